# Optimizing an MI355X kernel written in HIP

```python
import math
import jax, jax.numpy as jnp
from jax import lax
import numpy as np

D_MODEL = 1024
BATCH = 4
SEQ = 8192
DEPTH = 2

N_A_LAYERS = DEPTH // 2
N_B_LAYERS = DEPTH - N_A_LAYERS

SSM_WIDTH = D_MODEL
SSM_GROUP = 16
SSM_GROUPS = SSM_WIDTH // SSM_GROUP
SSM_STATE = 64
SSM_CHUNK = 128
DT_MIN = 1e-3
DT_MAX = 1e-1

N_HEADS = 8
HEAD_DIM = 64
V_HEAD_DIM = 2 * HEAD_DIM
QK_WIDTH = N_HEADS * 2 * HEAD_DIM
ATTN_WIDTH = N_HEADS * V_HEAD_DIM
ROT_DIM = HEAD_DIM // 4
ROPE_THETA = 500000.0
Q_BLOCK = 128

NORM_EPS = 1e-6
SUBLN_EPS = 1e-5

kernel_name = "yoco_s5_diffattn_hybrid"


def rmsnorm(x, g, eps=NORM_EPS):
    xf = x.astype(jnp.float32)
    xf = xf * lax.rsqrt(jnp.mean(xf * xf, axis=-1, keepdims=True) + eps)
    return xf.astype(x.dtype) * g


def rope_tables(seq):
    inv = ROPE_THETA ** (-jnp.arange(0, ROT_DIM, 2, dtype=jnp.float32) / ROT_DIM)
    ang = jnp.arange(seq, dtype=jnp.float32)[:, None] * inv[None, :]
    return jnp.cos(ang), jnp.sin(ang)


def partial_rope(x, cos, sin):
    half = ROT_DIM // 2
    x1 = x[..., :half].astype(jnp.float32)
    x2 = x[..., half:ROT_DIM].astype(jnp.float32)
    c = cos[:, None, :]
    s = sin[:, None, :]
    r1 = (x1 * c - x2 * s).astype(x.dtype)
    r2 = (x2 * c + x1 * s).astype(x.dtype)
    return jnp.concatenate([r1, r2, x[..., ROT_DIM:]], axis=-1)


def _complex_affine_combine(e1, e2):
    a1r, a1i, b1r, b1i = e1
    a2r, a2i, b2r, b2i = e2
    return (a2r * a1r - a2i * a1i,
            a2r * a1i + a2i * a1r,
            a2r * b1r - a2i * b1i + b2r,
            a2r * b1i + a2i * b1r + b2i)


def s5_ssm(u, lam_re, lam_im, log_dt, b_re, b_im, c_re, c_im, d_skip):
    bsz, seq, _ = u.shape
    dt = jnp.exp(log_dt)[:, None]
    mag = jnp.exp(lam_re * dt)
    ang = lam_im * dt
    abar_re = mag * jnp.cos(ang)
    abar_im = mag * jnp.sin(ang)
    den = lam_re * lam_re + lam_im * lam_im
    nr = abar_re - 1.0
    ni = abar_im
    f_re = (nr * lam_re + ni * lam_im) / den
    f_im = (ni * lam_re - nr * lam_im) / den
    bbar_re = f_re[..., None] * b_re - f_im[..., None] * b_im
    bbar_im = f_re[..., None] * b_im + f_im[..., None] * b_re

    n_chunks = seq // SSM_CHUNK
    u_c = u.reshape(bsz, n_chunks, SSM_CHUNK, SSM_GROUPS, SSM_GROUP).transpose(1, 2, 0, 3, 4)
    a_re_l = jnp.broadcast_to(abar_re[None, None], (SSM_CHUNK, bsz, SSM_GROUPS, SSM_STATE))
    a_im_l = jnp.broadcast_to(abar_im[None, None], (SSM_CHUNK, bsz, SSM_GROUPS, SSM_STATE))

    def step(carry, uc):
        s_re, s_im = carry
        bu_re = jnp.einsum('lbgh,gph->lbgp', uc, bbar_re)
        bu_im = jnp.einsum('lbgh,gph->lbgp', uc, bbar_im)
        acr, aci, xr, xi = lax.associative_scan(
            _complex_affine_combine, (a_re_l, a_im_l, bu_re, bu_im), axis=0)
        st_re = xr + acr * s_re - aci * s_im
        st_im = xi + acr * s_im + aci * s_re
        y = (jnp.einsum('lbgp,ghp->lbgh', st_re, c_re)
             - jnp.einsum('lbgp,ghp->lbgh', st_im, c_im))
        return (st_re[-1], st_im[-1]), y

    init = (jnp.zeros((bsz, SSM_GROUPS, SSM_STATE), jnp.float32),
            jnp.zeros((bsz, SSM_GROUPS, SSM_STATE), jnp.float32))
    _, y = lax.scan(step, init, u_c)
    y = y.transpose(2, 0, 1, 3, 4).reshape(bsz, seq, SSM_WIDTH)
    return y + d_skip * u


def s5_layer(h, g, in_w, lam_re, lam_im, log_dt, b_re, b_im, c_re, c_im, d_skip,
             glu_w, glu_b, out_w):
    f32 = jnp.float32
    xn = rmsnorm(h, g)
    uz = xn @ in_w
    u, z = jnp.split(uz, [SSM_WIDTH], axis=-1)
    y = s5_ssm(u.astype(f32), lam_re.astype(f32), lam_im.astype(f32), log_dt.astype(f32),
               b_re.astype(f32), b_im.astype(f32), c_re.astype(f32), c_im.astype(f32),
               d_skip.astype(f32)).astype(h.dtype)
    y = jax.nn.gelu(y, approximate=False)
    y = y * jax.nn.sigmoid(y @ glu_w + glu_b)
    y = y * jax.nn.silu(z)
    return y @ out_w


def shared_kv(h, g, kv_w, cos, sin):
    bsz, seq, _ = h.shape
    xn = rmsnorm(h, g)
    kv = xn @ kv_w
    k, v = jnp.split(kv, [QK_WIDTH], axis=-1)
    k = partial_rope(k.reshape(bsz, seq, 2 * N_HEADS, HEAD_DIM), cos, sin)
    k = k.reshape(bsz, seq, N_HEADS, 2, HEAD_DIM)
    k1 = k[..., 0, :].transpose(0, 2, 1, 3)
    k2 = k[..., 1, :].transpose(0, 2, 1, 3)
    v = v.reshape(bsz, seq, N_HEADS, V_HEAD_DIM).transpose(0, 2, 1, 3)
    return k1, k2, v


def diff_attention(q1, q2, k1, k2, v, lam):
    bsz, nh, seq, _ = q1.shape
    nb = seq // Q_BLOCK
    scale = HEAD_DIM ** -0.5
    kpos = jnp.arange(seq)

    def to_blocks(q):
        return q.reshape(bsz, nh, nb, Q_BLOCK, HEAD_DIM).transpose(2, 0, 1, 3, 4)

    def one_block(args):
        q1b, q2b, bi = args
        qpos = bi * Q_BLOCK + jnp.arange(Q_BLOCK)
        mask = kpos[None, :] <= qpos[:, None]

        def probs(qb, kk):
            s = jnp.einsum('bhqd,bhkd->bhqk', qb, kk).astype(jnp.float32) * scale
            return jax.nn.softmax(jnp.where(mask, s, -jnp.inf), axis=-1)

        p = probs(q1b, k1) - lam * probs(q2b, k2)
        return jnp.einsum('bhqk,bhkv->bhqv', p.astype(v.dtype), v)

    o = lax.map(one_block, (to_blocks(q1), to_blocks(q2), jnp.arange(nb)))
    return o.transpose(1, 0, 3, 2, 4).reshape(bsz, seq, nh, V_HEAD_DIM)


def diff_layer(h, g, in_w, lq1, lk1, lq2, lk2, subln_g, out_w, k1, k2, v, cos, sin, lam_init):
    bsz, seq, _ = h.shape
    xn = rmsnorm(h, g)
    qz = xn @ in_w
    q, z = jnp.split(qz, [QK_WIDTH], axis=-1)
    q = partial_rope(q.reshape(bsz, seq, 2 * N_HEADS, HEAD_DIM), cos, sin)
    q = q.reshape(bsz, seq, N_HEADS, 2, HEAD_DIM)
    q1 = q[..., 0, :].transpose(0, 2, 1, 3)
    q2 = q[..., 1, :].transpose(0, 2, 1, 3)
    f32 = jnp.float32
    lam = (jnp.exp(jnp.sum(lq1.astype(f32) * lk1.astype(f32)))
           - jnp.exp(jnp.sum(lq2.astype(f32) * lk2.astype(f32))) + lam_init)
    o = diff_attention(q1, q2, k1, k2, v, lam)
    o = rmsnorm(o, subln_g, SUBLN_EPS) * (1.0 - lam_init)
    o = o.reshape(bsz, seq, ATTN_WIDTH) * jax.nn.silu(z)
    return o @ out_w


def setup_inputs(seed: int = 0) -> dict:
    key = jax.random.key(seed)
    ks = jax.random.split(key, 32)
    f32 = jnp.float32
    nA, nB = N_A_LAYERS, N_B_LAYERS
    G, P, C = SSM_GROUPS, SSM_STATE, SSM_GROUP

    def nrm(k, shape, scale):
        return jax.random.normal(k, shape, f32) * scale

    x = jax.random.normal(ks[0], (BATCH, SEQ, D_MODEL), f32)
    a_norm_g = 1.0 + nrm(ks[1], (nA, D_MODEL), 0.02)
    a_in_w = nrm(ks[2], (nA, D_MODEL, 2 * SSM_WIDTH), D_MODEL ** -0.5)
    n_idx = jnp.arange(P, dtype=f32)
    a_lambda_re = -0.5 + nrm(ks[3], (nA, G, P), 0.01)
    a_lambda_im = jnp.broadcast_to(math.pi * n_idx, (nA, G, P)).astype(f32)
    a_log_dt = jax.random.uniform(ks[4], (nA, G), f32, math.log(DT_MIN), math.log(DT_MAX))
    a_b_re = nrm(ks[5], (nA, G, P, C), (2.0 * C) ** -0.5)
    a_b_im = nrm(ks[6], (nA, G, P, C), (2.0 * C) ** -0.5)
    a_c_re = nrm(ks[7], (nA, G, C, P), (2.0 * P) ** -0.5)
    a_c_im = nrm(ks[8], (nA, G, C, P), (2.0 * P) ** -0.5)
    a_d = nrm(ks[9], (nA, SSM_WIDTH), 1.0)
    a_glu_w = nrm(ks[10], (nA, SSM_WIDTH, SSM_WIDTH), SSM_WIDTH ** -0.5)
    a_glu_b = nrm(ks[11], (nA, SSM_WIDTH), 0.01)
    a_out_w = nrm(ks[12], (nA, SSM_WIDTH, D_MODEL), SSM_WIDTH ** -0.5)
    kv_norm_g = 1.0 + nrm(ks[13], (D_MODEL,), 0.02)
    kv_w = nrm(ks[14], (D_MODEL, QK_WIDTH + ATTN_WIDTH), D_MODEL ** -0.5)
    b_norm_g = 1.0 + nrm(ks[15], (nB, D_MODEL), 0.02)
    b_in_w = nrm(ks[16], (nB, D_MODEL, QK_WIDTH + ATTN_WIDTH), D_MODEL ** -0.5)
    b_lambda_q1 = nrm(ks[17], (nB, HEAD_DIM), 0.1)
    b_lambda_k1 = nrm(ks[18], (nB, HEAD_DIM), 0.1)
    b_lambda_q2 = nrm(ks[19], (nB, HEAD_DIM), 0.1)
    b_lambda_k2 = nrm(ks[20], (nB, HEAD_DIM), 0.1)
    b_subln_g = 1.0 + nrm(ks[21], (nB, V_HEAD_DIM), 0.02)
    b_out_w = nrm(ks[22], (nB, ATTN_WIDTH, D_MODEL), ATTN_WIDTH ** -0.5)
    final_norm_g = 1.0 + nrm(ks[23], (D_MODEL,), 0.02)
    return {"x": x, "a_norm_g": a_norm_g, "a_in_w": a_in_w, "a_lambda_re": a_lambda_re,
            "a_lambda_im": a_lambda_im, "a_log_dt": a_log_dt, "a_b_re": a_b_re, "a_b_im": a_b_im,
            "a_c_re": a_c_re, "a_c_im": a_c_im, "a_d": a_d, "a_glu_w": a_glu_w, "a_glu_b": a_glu_b,
            "a_out_w": a_out_w, "kv_norm_g": kv_norm_g, "kv_w": kv_w, "b_norm_g": b_norm_g,
            "b_in_w": b_in_w, "b_lambda_q1": b_lambda_q1, "b_lambda_k1": b_lambda_k1,
            "b_lambda_q2": b_lambda_q2, "b_lambda_k2": b_lambda_k2, "b_subln_g": b_subln_g,
            "b_out_w": b_out_w, "final_norm_g": final_norm_g}


def reference(x, a_norm_g, a_in_w, a_lambda_re, a_lambda_im, a_log_dt, a_b_re, a_b_im,
              a_c_re, a_c_im, a_d, a_glu_w, a_glu_b, a_out_w, kv_norm_g, kv_w, b_norm_g,
              b_in_w, b_lambda_q1, b_lambda_k1, b_lambda_q2, b_lambda_k2, b_subln_g,
              b_out_w, final_norm_g):
    seq = x.shape[1]
    cos, sin = rope_tables(seq)
    h = x
    k1 = k2 = v = None
    for l in range(DEPTH):
        if l < N_A_LAYERS:
            h = h + s5_layer(h, a_norm_g[l], a_in_w[l], a_lambda_re[l], a_lambda_im[l],
                             a_log_dt[l], a_b_re[l], a_b_im[l], a_c_re[l], a_c_im[l], a_d[l],
                             a_glu_w[l], a_glu_b[l], a_out_w[l])
        else:
            if l == N_A_LAYERS:
                k1, k2, v = shared_kv(h, kv_norm_g, kv_w, cos, sin)
            j = l - N_A_LAYERS
            lam_init = 0.8 - 0.6 * math.exp(-0.3 * l)
            h = h + diff_layer(h, b_norm_g[j], b_in_w[j], b_lambda_q1[j], b_lambda_k1[j],
                               b_lambda_q2[j], b_lambda_k2[j], b_subln_g[j], b_out_w[j],
                               k1, k2, v, cos, sin, lam_init)
    return rmsnorm(h, final_norm_g)
```

```cpp
#include <hip/hip_runtime.h>
#include <hip/hip_cooperative_groups.h>
#include <hip/hip_bf16.h>
#include <cstdio>
#include <cstdint>
#include <cmath>
namespace pg8 {
#define PG8_LAS __attribute__((address_space(3)))
typedef unsigned short bf16_t;
typedef short bf16x8 __attribute__((ext_vector_type(8)));
typedef float f32x4 __attribute__((ext_vector_type(4)));
typedef unsigned u32x4 __attribute__((ext_vector_type(4)));
constexpr int BM = 256, BK = 64, HALF = 128, HTB = HALF * BK * 2  , STAGE_BYTES = 8 * HTB, NXCD = 8, WGM = 8;

__host__ __device__ __forceinline__ int lds_byte(int r, int c) { const int st = (r >> 4) * 2 + (c >> 5), rr = r & 15, cc = c & 31, ob = rr * 64 + cc * 2; return st * 1024 + (ob ^ (((ob >> 9) & 1) << 5)); }
__host__ __device__ __forceinline__ void stage_rc(int b, int& R, int& C) { const int st = b / 1024, sb = b % 1024, swz = sb ^ (((sb >> 9) & 1) << 5); R = (st >> 1) * 16 + swz / 64; C = (st & 1) * 32 + (swz % 64) / 2; }
__host__ __device__ __forceinline__ int perm32(int rho) { const int n = rho >> 4, i = rho & 15; return 8 * (i >> 2) + 4 * n + (i & 3); }

struct Unit { int pm, pn; };
struct Gemm { const bf16_t* A; const bf16_t* Bt; int M, N, K; };

struct StaticOrder {
    int nM, nN, nwg, G, c;
    __host__ __device__ void init(int M, int N, int G_, int c_) { nM = M / BM; nN = N / BM; nwg = nM * nN; G = G_; c = c_; }
    __host__ __device__ bool next(int i, Unit& u) const {
        const long L = (long)i * G + c; if (L >= nwg) return false;
        int wgid = (int)L; { const int q = nwg / NXCD, r = nwg % NXCD, xcd = wgid % NXCD, off = wgid / NXCD; wgid = (xcd < r ? xcd * (q + 1) : r * (q + 1) + (xcd - r) * q) + off; }
        const int nig = WGM * nN, gid = wgid / nig, fm = gid * WGM, gsz = (nM - fm) < WGM ? (nM - fm) : WGM;
        u.pm = fm + ((wgid % nig) % gsz); u.pn = (wgid % nig) / gsz; return true;
    }
    __device__ __forceinline__ void a_ready(const Unit&) const {}
    __device__ __forceinline__ void done(const Unit&) const {}
};

__device__ __forceinline__ unsigned cvt_pk_bf16(float lo, float hi) { unsigned r; asm volatile("v_cvt_pk_bf16_f32 %0, %1, %2" : "=v"(r) : "v"(lo), "v"(hi)); return r; }
__device__ __forceinline__ int lane_id() { return (int)__builtin_amdgcn_mbcnt_hi(~0u, __builtin_amdgcn_mbcnt_lo(~0u, 0u)); }
__device__ __forceinline__ int lane_id_v() { int r; asm volatile("v_mbcnt_lo_u32_b32 %0, -1, 0\n\tv_mbcnt_hi_u32_b32 %0, -1, %0" : "=v"(r)); return r; }
__device__ __forceinline__ float bf_lo(unsigned w) { return __uint_as_float(w << 16); }
__device__ __forceinline__ float bf_hi(unsigned w) { return __uint_as_float(w & 0xffff0000u); }
__device__ __forceinline__ float sigm_f(float z) { return __builtin_amdgcn_rcpf(1.f + __builtin_amdgcn_exp2f(-1.4426950408889634f * z)); }
__device__ __forceinline__ float silu_f(float z) { return z * sigm_f(z); }
__device__ __forceinline__ u32x4 pack8(const f32x4 a, const f32x4 b) { u32x4 w; w.x = cvt_pk_bf16(a[0], a[1]); w.y = cvt_pk_bf16(a[2], a[3]); w.z = cvt_pk_bf16(b[0], b[1]); w.w = cvt_pk_bf16(b[2], b[3]); return w; }

struct EpiUZ {
    static constexpr bool PERM = true, AFTER_DRAIN = false;
    bf16_t* U; bf16_t* ZG; const float* rinv;
    __device__ __forceinline__ void operator()(const f32x4 (&acc)[2][2][4][2], const Unit& u, int wr, int wc, int fr, int fq) const {
        const bool isz = u.pn >= 4; bf16_t* base = isz ? ZG : U; const int colt = (isz ? u.pn - 4 : u.pn) * BM + wc * 32 + 8 * fq;
        float rv[2][4];
#pragma unroll
        for (int ai = 0; ai < 2; ++ai)
#pragma unroll
            for (int m = 0; m < 4; ++m) rv[ai][m] = rinv[u.pm * BM + ai * HALF + wr * 64 + m * 16 + fr];
#pragma unroll
        for (int ai = 0; ai < 2; ++ai)
#pragma unroll
            for (int m = 0; m < 4; ++m) { const int row = u.pm * BM + ai * HALF + wr * 64 + m * 16 + fr; const float ri = rv[ai][m];
                bf16_t* rowp = isz ? base + (size_t)row * 1024 + colt : base + ((size_t)((row >> 13) * 64 + (colt >> 4)) * 8192 + (row & 8191)) * 16 + (colt & 8);
                const size_t bjstep = isz ? (size_t)HALF : (size_t)(HALF / 16) * 8192 * 16;
#pragma unroll
                for (int bj = 0; bj < 2; ++bj) { f32x4 v0 = acc[ai][bj][m][0] * ri, v1 = acc[ai][bj][m][1] * ri;
                    if (isz) {
#pragma unroll
                        for (int k = 0; k < 4; ++k) { v0[k] = silu_f(v0[k]); v1[k] = silu_f(v1[k]); } }
                    *(u32x4*)(rowp + bj * bjstep) = pack8(v0, v1); } }
    }
};
struct EpiGlu {
    static constexpr bool PERM = true, AFTER_DRAIN = false;
    const bf16_t* YG; const bf16_t* ZG; const float* bias; bf16_t* Y2;
    __device__ __forceinline__ void operator()(const f32x4 (&acc)[2][2][4][2], const Unit& u, int wr, int wc, int fr, int fq) const {
        const int col0 = u.pn * BM + wc * 32 + 8 * fq;
        f32x4 bv[2][2];
#pragma unroll
        for (int bj = 0; bj < 2; ++bj)
#pragma unroll
            for (int n = 0; n < 2; ++n) bv[bj][n] = *(const f32x4*)(bias + col0 + bj * HALF + 4 * n);
#pragma unroll
        for (int ai = 0; ai < 2; ++ai) {
            u32x4 yw[4][2], zw[4][2];
#pragma unroll
            for (int m = 0; m < 4; ++m)
#pragma unroll
                for (int bj = 0; bj < 2; ++bj) { const size_t off = (size_t)(u.pm * BM + ai * HALF + wr * 64 + m * 16 + fr) * 1024 + col0 + bj * HALF; yw[m][bj] = *(const u32x4*)(YG + off); zw[m][bj] = *(const u32x4*)(ZG + off); }
#pragma unroll
            for (int m = 0; m < 4; ++m)
#pragma unroll
                for (int bj = 0; bj < 2; ++bj) { const size_t off = (size_t)(u.pm * BM + ai * HALF + wr * 64 + m * 16 + fr) * 1024 + col0 + bj * HALF;
                    const u32x4 y = yw[m][bj], z = zw[m][bj];
                    const f32x4 t0 = acc[ai][bj][m][0] + bv[bj][0], t1 = acc[ai][bj][m][1] + bv[bj][1];
                    f32x4 o0, o1;
                    o0[0] = bf_lo(y.x) * sigm_f(t0[0]) * bf_lo(z.x); o0[1] = bf_hi(y.x) * sigm_f(t0[1]) * bf_hi(z.x);
                    o0[2] = bf_lo(y.y) * sigm_f(t0[2]) * bf_lo(z.y); o0[3] = bf_hi(y.y) * sigm_f(t0[3]) * bf_hi(z.y);
                    o1[0] = bf_lo(y.z) * sigm_f(t1[0]) * bf_lo(z.z); o1[1] = bf_hi(y.z) * sigm_f(t1[1]) * bf_hi(z.z);
                    o1[2] = bf_lo(y.w) * sigm_f(t1[2]) * bf_lo(z.w); o1[3] = bf_hi(y.w) * sigm_f(t1[3]) * bf_hi(z.w);
                    *(u32x4*)(Y2 + off) = pack8(o0, o1); }
        }
    }
};
template <bool BASE_BF16> struct EpiRes {
    static constexpr bool PERM = true, AFTER_DRAIN = false;
    const void* X; bf16_t* HB; float* PSS;
    __device__ __forceinline__ void operator()(const f32x4 (&acc)[2][2][4][2], const Unit& u, int wr, int wc, int fr, int fq) const {
        const int col0 = u.pn * BM + wc * 32 + 8 * fq;
#pragma unroll
        for (int ai = 0; ai < 2; ++ai) {
            f32x4 b0[4][2], b1[4][2];
#pragma unroll
            for (int m = 0; m < 4; ++m)
#pragma unroll
                for (int bj = 0; bj < 2; ++bj) { const size_t off = (size_t)(u.pm * BM + ai * HALF + wr * 64 + m * 16 + fr) * 1024 + col0 + bj * HALF;
                    if (BASE_BF16) { const u32x4 w = *(const u32x4*)((const bf16_t*)X + off); b0[m][bj] = (f32x4){bf_lo(w.x), bf_hi(w.x), bf_lo(w.y), bf_hi(w.y)}; b1[m][bj] = (f32x4){bf_lo(w.z), bf_hi(w.z), bf_lo(w.w), bf_hi(w.w)}; }
                    else { b0[m][bj] = *(const f32x4*)((const float*)X + off); b1[m][bj] = *(const f32x4*)((const float*)X + off + 4); } }
#pragma unroll
            for (int m = 0; m < 4; ++m) { const int row = u.pm * BM + ai * HALF + wr * 64 + m * 16 + fr; float ss = 0.f;
#pragma unroll
                for (int bj = 0; bj < 2; ++bj) { const size_t off = (size_t)row * 1024 + col0 + bj * HALF;
                    const f32x4 h0 = b0[m][bj] + acc[ai][bj][m][0], h1 = b1[m][bj] + acc[ai][bj][m][1];
                    *(u32x4*)(HB + off) = pack8(h0, h1);
                    ss += (h0[0] * h0[0] + h0[1] * h0[1]) + (h0[2] * h0[2] + h0[3] * h0[3]) + (h1[0] * h1[0] + h1[1] * h1[1]) + (h1[2] * h1[2] + h1[3] * h1[3]); }
                ss += __shfl_xor(ss, 16); ss += __shfl_xor(ss, 32);
                if (fq == 0) PSS[(size_t)row * 16 + u.pn * 4 + wc] = ss; }
        }
    }
};
struct EpiKVQZ {
    static constexpr bool PERM = true, AFTER_DRAIN = false;
    bf16_t *K, *V, *Q, *ZG2; const float* PSS1; const float* ropec; const float* ropes; float qscale;
    __device__ __forceinline__ void operator()(const f32x4 (&acc)[2][2][4][2], const Unit& u, int wr, int wc, int fr, int fq) const {
        const int seg = u.pn >> 2; bf16_t* base = seg == 0 ? K : seg == 1 ? V : seg == 2 ? Q : ZG2; const int colt = (u.pn & 3) * BM + wc * 32 + 8 * fq;
        const bool roped = (seg == 0 || seg == 2) && ((wc & 1) == 0);
        const float sgn = fq == 0 ? -1.f : 1.f;
#pragma unroll
        for (int ai = 0; ai < 2; ++ai)
#pragma unroll
            for (int m = 0; m < 4; ++m) { const int row = u.pm * BM + ai * HALF + wr * 64 + m * 16 + fr;
                const f32x4* ps = (const f32x4*)(PSS1 + (size_t)row * 16); const f32x4 pa = ps[0], pb = ps[1], pc = ps[2], pd = ps[3];
                const float ssum = ((pa[0] + pa[1]) + (pa[2] + pa[3])) + ((pb[0] + pb[1]) + (pb[2] + pb[3])) + ((pc[0] + pc[1]) + (pc[2] + pc[3])) + ((pd[0] + pd[1]) + (pd[2] + pd[3]));
                float ri = 1.0f / sqrtf(ssum * (1.0f / 1024.0f) + 1e-6f); if (seg == 2) ri *= qscale;
                f32x4 c0, c1, s0, s1;
                if (roped) { const int pos = row & 8191; c0 = *(const f32x4*)(ropec + pos * 8); c1 = *(const f32x4*)(ropec + pos * 8 + 4); s0 = *(const f32x4*)(ropes + pos * 8); s1 = *(const f32x4*)(ropes + pos * 8 + 4); }
#pragma unroll
                for (int bj = 0; bj < 2; ++bj) { f32x4 v0 = acc[ai][bj][m][0] * ri, v1 = acc[ai][bj][m][1] * ri;
                    if (roped) { f32x4 p0, p1;
#pragma unroll
                        for (int k = 0; k < 4; ++k) { p0[k] = __shfl_xor(v0[k], 16); p1[k] = __shfl_xor(v1[k], 16); }
                        if (fq < 2) {
#pragma unroll
                            for (int k = 0; k < 4; ++k) { v0[k] = v0[k] * c0[k] + sgn * p0[k] * s0[k]; v1[k] = v1[k] * c1[k] + sgn * p1[k] * s1[k]; } } }
                    if (seg == 3) {
#pragma unroll
                        for (int k = 0; k < 4; ++k) { v0[k] = silu_f(v0[k]); v1[k] = silu_f(v1[k]); } }
                    *(u32x4*)(base + (size_t)row * 1024 + colt + bj * HALF) = pack8(v0, v1); } }
    }
};
template <class Epi, class Sched, bool ALIGN_EPI = false, bool SP2 = false>
__device__ __forceinline__ void gemm_phase(const int wv, PG8_LAS unsigned char* lds, const Gemm g, const Sched& S, const Epi& E) {
    const int lane = lane_id(), wid = wv, tid = wv * 64 + lane, wr = wid >> 2, wc = wid & 3, fr = lane & 15, fq = lane >> 4;
    const int K = g.K, nt = K / BK;
    unsigned voffA[2], voffB[2];
#pragma unroll
    for (int i = 0; i < 2; ++i) { int R, C; stage_rc(tid * 16 + i * 8192, R, C); const int Rb = Epi::PERM ? ((R & ~31) + perm32(R & 31)) : R;
        voffA[i] = (unsigned)(R * K + C) * 2u; voffB[i] = (unsigned)(Rb * K + C) * 2u; }
    const size_t kstep = (size_t)(BK * 2);
    const size_t hstep = (size_t)HALF * K * 2;
    const size_t tstep = 2 * hstep;
    const unsigned ldsw = (unsigned)wid * 1024u;
    const int aoff = lds_byte(wr * 64 + fr, fq * 8), boff = lds_byte(wc * 32 + fr, fq * 8);
#define PG8_SA(b, h) (((b) * 2 + (h)) * HTB)
#define PG8_SB(b, h) ((4 + (b) * 2 + (h)) * HTB)
#define PG8_STAGE(bufoff, gbase, voff) do { _Pragma("unroll") for (int _i = 0; _i < 2; ++_i) \
        __builtin_amdgcn_global_load_lds((const unsigned*)((const char*)(gbase) + (voff)[_i]), (PG8_LAS unsigned*)(lds + (bufoff) + ldsw + _i * 8192), 16, 0, 0); } while (0)
#define PG8_LDA(dst, b, h) do { _Pragma("unroll") for (int m = 0; m < 4; ++m) _Pragma("unroll") for (int k = 0; k < 2; ++k) dst[m][k] = *(const PG8_LAS bf16x8*)(lds + PG8_SA(b, h) + aoff + m * 2048 + k * 1024); } while (0)
#define PG8_LDB(dst, b, h) do { _Pragma("unroll") for (int n = 0; n < 2; ++n) _Pragma("unroll") for (int k = 0; k < 2; ++k) dst[n][k] = *(const PG8_LAS bf16x8*)(lds + PG8_SB(b, h) + boff + n * 2048 + k * 1024); } while (0)
#define PG8_MMA(ai, bj, At, Bt) do { __builtin_amdgcn_s_setprio(1); _Pragma("unroll") for (int m = 0; m < 4; ++m) _Pragma("unroll") for (int n = 0; n < 2; ++n) _Pragma("unroll") for (int k = 0; k < 2; ++k) \
        acc[ai][bj][m][n] = __builtin_amdgcn_mfma_f32_16x16x32_bf16(Bt[n][k], At[m][k], acc[ai][bj][m][n], 0, 0, 0); __builtin_amdgcn_s_setprio(0); } while (0)
#define PG8_WAIT_V(n) asm volatile("s_waitcnt vmcnt(" #n ")" ::: "memory")
#define PG8_WAIT_L(n) asm volatile("s_waitcnt lgkmcnt(" #n ")" ::: "memory")
#define PG8_BAR __builtin_amdgcn_s_barrier()
#define PG8_SCHED __builtin_amdgcn_sched_barrier(0)
    Unit cur, nxt; int ui = 0;
    if (!S.next(0, cur)) return;
    f32x4 acc[2][2][4][2];
#pragma unroll
    for (int a = 0; a < 2; ++a)
#pragma unroll
        for (int b = 0; b < 2; ++b)
#pragma unroll
            for (int m = 0; m < 4; ++m)
#pragma unroll
                for (int n = 0; n < 2; ++n) acc[a][b][m][n] = (f32x4){0.f, 0.f, 0.f, 0.f};
    bf16x8 At[4][2], B0[2][2], B1[2][2];
    const char* cA = (const char*)g.A + (size_t)cur.pm * tstep; const char* cB = (const char*)g.Bt + (size_t)cur.pn * tstep;
    S.a_ready(cur);
    if constexpr (SP2) {
        PG8_STAGE(PG8_SB(0, 0), cB, voffB); PG8_STAGE(PG8_SB(0, 1), cB + hstep, voffB); PG8_STAGE(PG8_SA(0, 0), cA, voffA); PG8_STAGE(PG8_SA(0, 1), cA + hstep, voffA);
        if (wr == 1) PG8_BAR;
        PG8_WAIT_V(2); PG8_BAR;
        PG8_STAGE(PG8_SB(1, 0), cB + kstep, voffB); PG8_STAGE(PG8_SA(1, 0), cA + kstep, voffA); PG8_STAGE(PG8_SB(1, 1), cB + hstep + kstep, voffB);
        PG8_WAIT_V(6); PG8_BAR;
    } else {
        PG8_STAGE(PG8_SB(0, 0), cB, voffB); PG8_STAGE(PG8_SA(0, 0), cA, voffA); PG8_STAGE(PG8_SB(0, 1), cB + hstep, voffB); PG8_STAGE(PG8_SA(0, 1), cA + hstep, voffA);
        if (wr == 1) PG8_BAR;
        PG8_WAIT_V(4); PG8_BAR;
        PG8_STAGE(PG8_SB(1, 0), cB + kstep, voffB); PG8_STAGE(PG8_SA(1, 0), cA + kstep, voffA); PG8_STAGE(PG8_SB(1, 1), cB + hstep + kstep, voffB);
        PG8_WAIT_V(6); PG8_BAR;
    }
    for (;;) {
        const bool has_next = S.next(ui + 1, nxt);
        const char* nA = has_next ? (const char*)g.A + (size_t)nxt.pm * tstep : cA; const char* nB = has_next ? (const char*)g.Bt + (size_t)nxt.pn * tstep : cB;
        for (int t = 0; t < nt; t += 2) {
            const bool last = (t == nt - 2);
            const char* a1 = cA + (size_t)(t + 1) * kstep;
            const char* a2 = last ? nA : cA + (size_t)(t + 2) * kstep; const char* b2 = last ? nB : cB + (size_t)(t + 2) * kstep;
            const char* a3 = a2 + kstep; const char* b3 = b2 + kstep;
            if (last && has_next) S.a_ready(nxt);
            if constexpr (SP2) {
            PG8_LDB(B0, 0, 0); PG8_LDB(B1, 0, 1); PG8_SCHED; PG8_LDA(At, 0, 0); PG8_STAGE(PG8_SA(1, 1), a1 + hstep, voffA);
            PG8_WAIT_V(8); PG8_WAIT_L(0); PG8_BAR; PG8_MMA(0, 0, At, B0); PG8_MMA(0, 1, At, B1); PG8_BAR; PG8_SCHED;
            PG8_LDA(At, 0, 1); PG8_STAGE(PG8_SB(0, 0), b2, voffB); PG8_STAGE(PG8_SB(0, 1), b2 + hstep, voffB); PG8_STAGE(PG8_SA(0, 0), a2, voffA);
            PG8_WAIT_V(8); PG8_WAIT_L(0); PG8_BAR; PG8_MMA(1, 0, At, B0); PG8_MMA(1, 1, At, B1); PG8_BAR; PG8_SCHED;
            PG8_LDB(B0, 1, 0); PG8_LDB(B1, 1, 1); PG8_SCHED; PG8_LDA(At, 1, 0); PG8_STAGE(PG8_SA(0, 1), a2 + hstep, voffA);
            PG8_WAIT_V(8); PG8_WAIT_L(0); PG8_BAR; PG8_MMA(0, 0, At, B0); PG8_MMA(0, 1, At, B1); PG8_BAR; PG8_SCHED;
            PG8_LDA(At, 1, 1); PG8_STAGE(PG8_SB(1, 0), b3, voffB); PG8_STAGE(PG8_SB(1, 1), b3 + hstep, voffB); PG8_STAGE(PG8_SA(1, 0), a3, voffA);
            PG8_WAIT_V(8); PG8_WAIT_L(0); PG8_BAR; PG8_MMA(1, 0, At, B0); PG8_MMA(1, 1, At, B1); PG8_BAR; PG8_SCHED;
            } else {
            PG8_LDB(B0, 0, 0); PG8_SCHED; PG8_LDA(At, 0, 0); PG8_STAGE(PG8_SA(1, 1), a1 + hstep, voffA);
            PG8_WAIT_L(8); PG8_BAR; PG8_WAIT_L(0); PG8_MMA(0, 0, At, B0); PG8_BAR; PG8_SCHED;
            PG8_LDB(B1, 0, 1); PG8_STAGE(PG8_SB(0, 0), b2, voffB);
            PG8_BAR; PG8_WAIT_L(0); PG8_MMA(0, 1, At, B1); PG8_BAR;
            PG8_LDA(At, 0, 1); PG8_STAGE(PG8_SA(0, 0), a2, voffA);
            PG8_BAR; PG8_WAIT_L(0); PG8_MMA(1, 0, At, B0); PG8_BAR; PG8_SCHED;
            PG8_STAGE(PG8_SB(0, 1), b2 + hstep, voffB);
            PG8_WAIT_V(6); PG8_BAR; PG8_MMA(1, 1, At, B1); PG8_BAR;
            PG8_LDB(B0, 1, 0); PG8_SCHED; PG8_LDA(At, 1, 0); PG8_STAGE(PG8_SA(0, 1), a2 + hstep, voffA);
            PG8_WAIT_L(8); PG8_BAR; PG8_WAIT_L(0); PG8_MMA(0, 0, At, B0); PG8_BAR; PG8_SCHED;
            PG8_LDB(B1, 1, 1); PG8_STAGE(PG8_SB(1, 0), b3, voffB);
            PG8_BAR; PG8_WAIT_L(0); PG8_MMA(0, 1, At, B1); PG8_BAR;
            PG8_LDA(At, 1, 1); PG8_STAGE(PG8_SA(1, 0), a3, voffA);
            PG8_BAR; PG8_WAIT_L(0); PG8_MMA(1, 0, At, B0); PG8_BAR; PG8_SCHED;
            PG8_STAGE(PG8_SB(1, 1), b3 + hstep, voffB);
            PG8_WAIT_V(6); PG8_BAR; PG8_MMA(1, 1, At, B1); PG8_BAR;
            }
        }
        if constexpr (ALIGN_EPI) { if (wr == 0) PG8_BAR; }
        if constexpr (!Epi::AFTER_DRAIN) { E(acc, cur, wr, wc, fr, fq); S.done(cur); }
        if (!has_next) break;
#pragma unroll
        for (int a = 0; a < 2; ++a)
#pragma unroll
            for (int b = 0; b < 2; ++b)
#pragma unroll
                for (int m = 0; m < 4; ++m)
#pragma unroll
                    for (int n = 0; n < 2; ++n) acc[a][b][m][n] = (f32x4){0.f, 0.f, 0.f, 0.f};
        cur = nxt; cA = nA; cB = nB; ++ui;
        if constexpr (ALIGN_EPI) { if (wr == 1) PG8_BAR; }
    }
    PG8_WAIT_V(0);
    if constexpr (!ALIGN_EPI) { if (wr == 0) PG8_BAR; }
    PG8_BAR;
    if constexpr (Epi::AFTER_DRAIN) { E.fused(acc, cur, wr, wc, fr, fq, lds, wid, lane); S.done(cur); }
#undef PG8_SA
#undef PG8_SB
#undef PG8_STAGE
#undef PG8_LDA
#undef PG8_LDB
#undef PG8_MMA
#undef PG8_WAIT_V
#undef PG8_WAIT_L
#undef PG8_BAR
#undef PG8_SCHED
}
}
#define PG8_SP2 true
#define PG8_ALIGN true
namespace attn_body {
using bf16=__hip_bfloat16;
using bf16x8=__attribute__((ext_vector_type(8)))short;
using s16x4=__attribute__((ext_vector_type(4)))short;
using f32x16=__attribute__((ext_vector_type(16)))float;
using u32x4=__attribute__((ext_vector_type(4)))unsigned;
constexpr int BATCH=4,NHEAD=16,SEQ=8192,D=64,DM=NHEAD*D;
constexpr int NW=8,QBLK=32,QB=QBLK*NW,KVBLK=64,NQB=SEQ/QB;
constexpr int ATTN_PITCH=DM, ATTN_UNIT_ROWS=QB;
__device__ __forceinline__ int crow(int r,int hi){return (r&3)+8*(r>>2)+4*hi;}
#define SBAR() __builtin_amdgcn_sched_barrier(0)
__device__ __forceinline__ void cmask(f32x16&p0,f32x16&p1,int jb,int qrel,int hi){
  const float NEG=-INFINITY; int kb=64*jb+4*hi;
  #pragma unroll
  for(int r=0;r<16;++r){int kv=kb+(r&3)+8*(r>>2); if(kv>qrel)p0[r]=NEG; if(kv+32>qrel)p1[r]=NEG;}
}

constexpr int NSLOT=3, SLOTB=8192;
constexpr int LDS_K=0, LDS_V=NSLOT*SLOTB, LDS_WS=3*NSLOT*SLOTB, LDS_OST=LDS_WS+NW*64*4, LDS_BYTES=LDS_OST+NW*8192;
constexpr float C2=0.125f*1.4426950408889634f;
__device__ __forceinline__ void glds16(const void*gsrc,unsigned lds_dst){unsigned keep;
  asm volatile("s_mov_b32 %0, m0\n\ts_mov_b32 m0, %2\n\ts_nop 0\n\tglobal_load_lds_dwordx4 %1, off\n\ts_mov_b32 m0, %0":"=&s"(keep):"v"(gsrc),"s"(lds_dst):"memory");}
__device__ __forceinline__ int lane_opaque(){int r;asm volatile("v_mbcnt_lo_u32_b32 %0, -1, 0\n\tv_mbcnt_hi_u32_b32 %0, -1, %0":"=v"(r));return r;}
__device__ __forceinline__ float max3f(float a,float b,float c){float r;asm("v_max3_f32 %0, %1, %2, %3":"=v"(r):"v"(a),"v"(b),"v"(c));return r;}
__device__ __forceinline__ float max2f(float a,float b){float r;asm("v_max_f32_e32 %0, %1, %2":"=v"(r):"v"(a),"v"(b));return r;}
__device__ __forceinline__ float fadd_s(float a,float b){float r;asm("v_add_f32_e32 %0, %1, %2":"=v"(r):"v"(a),"v"(b));return r;}
__device__ __forceinline__ float fsub_s(float a,float b){float r;asm("v_sub_f32_e32 %0, %1, %2":"=v"(r):"v"(a),"v"(b));return r;}
typedef float f32x2_t __attribute__((ext_vector_type(2))); typedef __bf16 bf16x2_t __attribute__((ext_vector_type(2)));
__device__ __forceinline__ unsigned cvtpk_s(float lo,float hi){f32x2_t v={lo,hi};bf16x2_t b=__builtin_convertvector(v,bf16x2_t);return __builtin_bit_cast(unsigned,b);}
#define WAIT_BAR(N) asm volatile("s_waitcnt vmcnt(" #N ") lgkmcnt(0)\n\ts_barrier":::"memory")

__device__ __forceinline__ void qkt(f32x16&p0,f32x16&p1,const char*Kslot,const bf16x8*qr,int r32,int hi){
  const char*kb=Kslot+hi*1024+r32*16;
  #pragma unroll
  for(int d0=0;d0<4;++d0){
    const bf16x8 b0=*reinterpret_cast<const bf16x8*>(kb+d0*2048);
    const bf16x8 b1=*reinterpret_cast<const bf16x8*>(kb+d0*2048+512);
    if(d0==0){p0=__builtin_amdgcn_mfma_f32_32x32x16_bf16(b0,qr[0],f32x16{},0,0,0);p1=__builtin_amdgcn_mfma_f32_32x32x16_bf16(b1,qr[0],f32x16{},0,0,0);}
    else{p0=__builtin_amdgcn_mfma_f32_32x32x16_bf16(b0,qr[d0],p0,0,0,0);p1=__builtin_amdgcn_mfma_f32_32x32x16_bf16(b1,qr[d0],p1,0,0,0);}}
}
typedef __attribute__((address_space(3))) const char* lds_cptr;
typedef short v4i16_t __attribute__((ext_vector_type(4)));
__device__ __forceinline__ void kload8(bf16x8*kf,lds_cptr kp){
  kf[0]=*(const __attribute__((address_space(3))) bf16x8*)(kp);      kf[1]=*(const __attribute__((address_space(3))) bf16x8*)(kp+512);
  kf[2]=*(const __attribute__((address_space(3))) bf16x8*)(kp+2048); kf[3]=*(const __attribute__((address_space(3))) bf16x8*)(kp+2560);
  kf[4]=*(const __attribute__((address_space(3))) bf16x8*)(kp+4096); kf[5]=*(const __attribute__((address_space(3))) bf16x8*)(kp+4608);
  kf[6]=*(const __attribute__((address_space(3))) bf16x8*)(kp+6144); kf[7]=*(const __attribute__((address_space(3))) bf16x8*)(kp+6656);
}
__device__ __forceinline__ void kload2(bf16x8*kf,lds_cptr kp,int j){ kf[2*j]=*(const __attribute__((address_space(3))) bf16x8*)(kp+j*2048); kf[2*j+1]=*(const __attribute__((address_space(3))) bf16x8*)(kp+j*2048+512); }
__device__ __forceinline__ s16x4 vtr(lds_cptr p){ return __builtin_bit_cast(s16x4,__builtin_amdgcn_ds_read_tr16_b64_v4i16((__attribute__((address_space(3))) v4i16_t*)p)); }
__device__ __forceinline__ float rowmax(const f32x16&p0,const f32x16&p1){
  float a=max3f(p0[0],p0[1],p1[0]),b=max3f(p0[2],p0[3],p1[1]);a=max3f(a,p1[2],p1[3]);
  #pragma unroll
  for(int r=4;r<16;r+=4){a=max3f(a,p0[r],p0[r+1]);b=max3f(b,p0[r+2],p0[r+3]);a=max3f(a,p1[r],p1[r+1]);b=max3f(b,p1[r+2],p1[r+3]);}
  const float m=max2f(a,b);
  auto rr=__builtin_amdgcn_permlane32_swap(__float_as_uint(m),__float_as_uint(m),false,false);
  return max2f(__uint_as_float(rr[0]),__uint_as_float(rr[1]));
}
__device__ __forceinline__ void pv(f32x16*o,int vb,bf16x8 pa0,bf16x8 pa1,bf16x8 pa2,bf16x8 pa3){
  #pragma unroll
  for(int d0=0;d0<4;++d0){s16x4 lo[4],hi[4];
    #pragma unroll
    for(int ks=0;ks<4;++ks){
      asm volatile("ds_read_b64_tr_b16 %0,%1 offset:%c2":"=&v"(lo[ks]):"v"(vb),"i"((d0>>1)*8192+(d0&1)*4096+ks*1024):"memory");
      asm volatile("ds_read_b64_tr_b16 %0,%1 offset:%c2":"=&v"(hi[ks]):"v"(vb),"i"((d0>>1)*8192+(d0&1)*4096+ks*1024+512):"memory");}
    asm volatile("s_waitcnt lgkmcnt(0)":::"memory");SBAR();
    #define PK(k) (bf16x8){lo[k][0],lo[k][1],lo[k][2],lo[k][3],hi[k][0],hi[k][1],hi[k][2],hi[k][3]}
    o[d0]=__builtin_amdgcn_mfma_f32_32x32x16_bf16(pa0,PK(0),o[d0],0,0,0);
    o[d0]=__builtin_amdgcn_mfma_f32_32x32x16_bf16(pa1,PK(1),o[d0],0,0,0);
    o[d0]=__builtin_amdgcn_mfma_f32_32x32x16_bf16(pa2,PK(2),o[d0],0,0,0);
    o[d0]=__builtin_amdgcn_mfma_f32_32x32x16_bf16(pa3,PK(3),o[d0],0,0,0);
    #undef PK
  }
}

#ifndef ATTN_STORE16
#define ATTN_STORE16(p,v) (*(u32x4*)(p)=(v))
#endif
struct Comb { const bf16* ZG; bf16* A2; const float* subg; float lam, oml; };
template<int THRL> __device__ __forceinline__ void attn_unit(const int MODE,const int wv,int b,int h,int vcol,int qb,const bf16*Q,const bf16*__restrict__ K,const bf16*__restrict__ V,bf16*O,char*shm,const Comb&ca){
  const int lane=pg8::lane_id(),r32=lane&31,hi=lane>>5; const int wid=wv;
  const long rowbase=(long)b*SEQ; const int q0=qb*QB;
  const bf16*Qw=Q+(rowbase+q0+wid*QBLK)*DM+h*D;
  const bf16*Kh=K+rowbase*DM+h*D,*Vh=V+rowbase*DM+vcol;
  const unsigned lds0=(unsigned)(uintptr_t)shm;
  float*wsf=(float*)(shm+LDS_WS)+wid*64;
  const bf16*ksrc=Kh+(long)lane*DM+wid*8;
  const bf16*vsrc=Vh+(long)(16*(wid&3)+(lane>>2))*DM+(wid>>2)*32+(lane&3)*8;
  const unsigned kdst=lds0+LDS_K+wid*1024, vdst=lds0+LDS_V+wid*1024;
  #define DMA_K(t,slot) glds16(ksrc+(long)(t)*KVBLK*DM,(unsigned)__builtin_amdgcn_readfirstlane(kdst+(slot)))
  #define DMA_V(t,slot) do{ glds16(vsrc+(long)(t)*KVBLK*DM,(unsigned)__builtin_amdgcn_readfirstlane(vdst+2*(slot))); glds16(vsrc+64+(long)(t)*KVBLK*DM,(unsigned)__builtin_amdgcn_readfirstlane(vdst+2*(slot)+8192)); }while(0)
  const char*Kbase=shm+LDS_K; bf16x8 kf[8];
  const lds_cptr shm3=(lds_cptr)shm; const lds_cptr kp0=shm3+LDS_K+hi*1024+r32*16; const lds_cptr vp0=shm3+LDS_V+((lane>>4)&1)*32+(lane&3)*8+(4*hi+((lane&15)>>2))*64;
  const int NT=(q0+QB)/KVBLK;
  DMA_K(0,0);DMA_V(0,0);DMA_K(1,SLOTB);
  bf16x8 qr[4];
  #pragma unroll
  for(int d0=0;d0<4;++d0)qr[d0]=*reinterpret_cast<const bf16x8*>(&Qw[(long)r32*DM+d0*16+hi*8]);
  const lds_cptr qp_=shm3+LDS_OST+wid*8192+lane*16;
  #define QLD(d) (*(const __attribute__((address_space(3))) bf16x8*)(qp_+(d)*1024))
  float mhat=0.f,l_reg=0.f;f32x16 o[4];o[0]=f32x16{};o[1]=f32x16{};o[2]=f32x16{};o[3]=f32x16{};
  const int qrel=wid*QBLK+r32;
  #define CMASK(P0,P1,t) do{int jb_=(t)-(NT-4); if(jb_>=0)cmask(P0,P1,jb_,qrel,hi);}while(0)
  bool resc=false;
  #define START(P0,P1) do{ const float rm=rowmax(P0,P1); resc=false; \
    { const float dl=rm; mhat=fadd_s(mhat,dl); \
      _Pragma("unroll") for(int r=0;r<16;++r){P0[r]=fsub_s(P0[r],dl);P1[r]=fsub_s(P1[r],dl);} \
      } \
    _Pragma("unroll") for(int r=0;r<16;++r)P0[r]=__builtin_amdgcn_exp2f(P0[r]); }while(0)
  #define RESC() do{ if(resc){ asm volatile("s_waitcnt lgkmcnt(0)":::"memory"); \
      _Pragma("unroll") for(int d_=0;d_<4;++d_) _Pragma("unroll") for(int r=0;r<16;++r)o[d_][r]*=wsf[crow(r,hi)]; } }while(0)
  f32x16 pA0,pA1,pB0,pB1;
  int sl_prev=0,sl_cur=0,sl_next=SLOTB;
  #define ROT() do{sl_prev=sl_cur;sl_cur=sl_next;sl_next=(sl_next==(NSLOT-1)*SLOTB)?0:sl_next+SLOTB;}while(0)
  DMA_K(2,2*SLOTB);
  _Pragma("unroll") for(int d0=0;d0<4;++d0)*(__attribute__((address_space(3))) bf16x8*)(qp_+d0*1024)=qr[d0];
  WAIT_BAR(3);
  qkt(pA0,pA1,Kbase,qr,r32,hi);asm volatile("s_nop 15\n\ts_nop 7":"+v"(pA0),"+v"(pA1));CMASK(pA0,pA1,0);
  START(pA0,pA1);
  _Pragma("unroll") for(int r=0;r<16;++r)pA1[r]=__builtin_amdgcn_exp2f(pA1[r]);
  WAIT_BAR(0);
  DMA_K(3,0);DMA_V(1,SLOTB);
  ROT();
  kload8(kf,kp0+sl_cur);
  WAIT_BAR(3);
  s16x4 vlo[4],vhi[4]; u32x4 pw0,pw1,pw2,pw3;
  #define PKW(P,B) cvtpk_s(P[B],P[B+1])
  #define PAF(k) __builtin_bit_cast(bf16x8,pw##k)
  #define PIN(x) asm volatile("":"+v"(x))
  #define MX3(a,b,c) __builtin_fmaxf(__builtin_fmaxf((a),(b)),(c))
  #define GAPA(MF,A0,A1,A2,A3,W0,W1,PW) do{ MF; sacc+=A0; sacc+=A1; sacc+=A2; sacc+=A3; PIN(sacc); W0; W1; PIN(PW); SBAR(); }while(0)
  #define EX(v) __builtin_amdgcn_exp2f(v)
  #define GAPB(MF,X,B) do{ MF; X[B]=EX(X[B]-mhat); X[B+1]=EX(X[B+1]-mhat); PIN(X); SBAR(); }while(0)
  #define VRN(f) do{ vlo[(f)&3]=vtr(vp_+((((f)&3)>>1)*8192+((f)&1)*4096+((f)>>2)*1024)); vhi[(f)&3]=vtr(vp_+((((f)&3)>>1)*8192+((f)&1)*4096+((f)>>2)*1024+512)); }while(0)
  #define VFQ(i) (bf16x8){vlo[i][0],vlo[i][1],vlo[i][2],vlo[i][3],vhi[i][0],vhi[i][1],vhi[i][2],vhi[i][3]}
  #define MFB(k,d) o[d]=__builtin_amdgcn_mfma_f32_32x32x16_bf16(PAF(k),VFQ(d),o[d],0,0,0)
  #define KRD(G,j) do{ if(G){ kload2(kf,kp0+sl_next,j); SBAR(); } }while(0)
  #define STEP(C0,C1,P0,P1,t,GK,GV,GL) do{ SBAR(); \
    const lds_cptr vp_=vp0+2*sl_prev; \
    bf16x8 qa_=QLD(0), qb_=QLD(1); float sacc=(P0[0]+P0[1]); \
    GAPA(C0=__builtin_amdgcn_mfma_f32_32x32x16_bf16(kf[0],qa_,f32x16{},0,0,0), P0[2],P0[3],P0[4],P0[5],     pw0[0]=PKW(P0,0), pw0[1]=PKW(P0,2), pw0); \
    GAPA(C1=__builtin_amdgcn_mfma_f32_32x32x16_bf16(kf[1],qa_,f32x16{},0,0,0), P0[6],P0[7],P0[8],P0[9],     pw0[2]=PKW(P0,4), pw0[3]=PKW(P0,6), pw0); \
    qa_=QLD(2); \
    GAPA(C0=__builtin_amdgcn_mfma_f32_32x32x16_bf16(kf[2],qb_,C0,0,0,0),   P0[10],P0[11],P0[12],P0[13], pw1[0]=PKW(P0,8), pw1[1]=PKW(P0,10), pw1); \
    GAPA(C1=__builtin_amdgcn_mfma_f32_32x32x16_bf16(kf[3],qb_,C1,0,0,0),   P0[14],P0[15],P1[0],P1[1],   pw1[2]=PKW(P0,12),pw1[3]=PKW(P0,14), pw1); \
    qb_=QLD(3); \
    GAPA(C0=__builtin_amdgcn_mfma_f32_32x32x16_bf16(kf[4],qa_,C0,0,0,0),   P1[2],P1[3],P1[4],P1[5],     pw2[0]=PKW(P1,0), pw2[1]=PKW(P1,2), pw2); \
    GAPA(C1=__builtin_amdgcn_mfma_f32_32x32x16_bf16(kf[5],qa_,C1,0,0,0),   P1[6],P1[7],P1[8],P1[9],     pw2[2]=PKW(P1,4), pw2[3]=PKW(P1,6), pw2); \
    GAPA(C0=__builtin_amdgcn_mfma_f32_32x32x16_bf16(kf[6],qb_,C0,0,0,0),   P1[10],P1[11],P1[12],P1[13], pw3[0]=PKW(P1,8), pw3[1]=PKW(P1,10), pw3); \
    GAPA(C1=__builtin_amdgcn_mfma_f32_32x32x16_bf16(kf[7],qb_,C1,0,0,0),   P1[14],P1[15],0.f,0.f,       pw3[2]=PKW(P1,12),pw3[3]=PKW(P1,14), pw3); \
    l_reg+=sacc; \
    if(GK){DMA_K((t)+3,sl_cur);} if(GV){DMA_V((t)+1,sl_next);} \
    VRN(0); VRN(1); VRN(2); \
    CMASK(C0,C1,t); \
    { float a=MX3(C0[0],C0[1],C1[0]),b=MX3(C0[2],C0[3],C1[1]); a=MX3(a,C1[2],C1[3]); \
      _Pragma("unroll") for(int r=4;r<16;r+=4){a=MX3(a,C0[r],C0[r+1]);b=MX3(b,C0[r+2],C0[r+3]);a=MX3(a,C1[r],C1[r+1]);b=MX3(b,C1[r+2],C1[r+3]);} \
      float rm=__builtin_fmaxf(a,b); { auto rr=__builtin_amdgcn_permlane32_swap(__float_as_uint(rm),__float_as_uint(rm),false,false); rm=__builtin_fmaxf(__uint_as_float(rr[0]),__uint_as_float(rr[1]))-mhat; } \
      resc=false; \
      if(__builtin_expect(__any(rm>(float)THRL),0)){ const float dl=__builtin_fmaxf(rm,0.f); mhat+=dl; \
        const float f=__builtin_amdgcn_exp2f(-dl); l_reg*=f; if(hi==0)wsf[lane_opaque()&31]=f; resc=true; } } \
    SBAR(); \
    VRN(3);  GAPB(MFB(0,0), C0,0); \
    VRN(4);  GAPB(MFB(0,1), C0,2); \
    VRN(5);  GAPB(MFB(0,2), C0,4); \
    VRN(6);  GAPB(MFB(0,3), C0,6); \
    KRD(GL,0); VRN(7);  GAPB(MFB(1,0), C0,8); \
    VRN(8);  GAPB(MFB(1,1), C0,10); \
    KRD(GL,1); VRN(9);  GAPB(MFB(1,2), C0,12); \
    VRN(10); GAPB(MFB(1,3), C0,14); \
    KRD(GL,2); VRN(11); GAPB(MFB(2,0), C1,0); \
    VRN(12); GAPB(MFB(2,1), C1,2); \
    KRD(GL,3); VRN(13); GAPB(MFB(2,2), C1,4); \
    VRN(14); GAPB(MFB(2,3), C1,6); \
    VRN(15); GAPB(MFB(3,0), C1,8); \
    GAPB(MFB(3,1), C1,10); \
    GAPB(MFB(3,2), C1,12); \
    GAPB(MFB(3,3), C1,14); \
    }while(0)
  int t=1;
  #undef CMASK
  #define CMASK(P0,P1,t) do{}while(0)
  for(;t+5<NT;t+=2){
    STEP(pB0,pB1,pA0,pA1,t,true,true,true);     WAIT_BAR(3); RESC(); ROT();
    STEP(pA0,pA1,pB0,pB1,t+1,true,true,true);   WAIT_BAR(3); RESC(); ROT();
  }
  #undef CMASK
  #define CMASK(P0,P1,t) do{int jb_=(t)-(NT-4); if(jb_>=0)cmask(P0,P1,jb_,qrel,hi);}while(0)
  #define ENDW(tt) do{ if((tt)+3<NT){WAIT_BAR(3);} else if((tt)+2<NT){WAIT_BAR(2);} else {WAIT_BAR(0);} }while(0)
  for(;t+1<NT;t+=2){
    STEP(pB0,pB1,pA0,pA1,t,(t+3<NT),(t+1<NT),(t+1<NT));       ENDW(t);   RESC(); ROT();
    STEP(pA0,pA1,pB0,pB1,t+1,(t+4<NT),(t+2<NT),(t+2<NT));     ENDW(t+1); RESC(); ROT();
  }
  STEP(pB0,pB1,pA0,pA1,NT-1,false,false,false); RESC();
  { float sacc=pB0[0]+pB0[1]; _Pragma("unroll") for(int r=2;r<16;++r)sacc+=pB0[r]; _Pragma("unroll") for(int r=0;r<16;++r)sacc+=pB1[r]; l_reg+=sacc;
    pw0=(u32x4){PKW(pB0,0),PKW(pB0,2),PKW(pB0,4),PKW(pB0,6)};pw1=(u32x4){PKW(pB0,8),PKW(pB0,10),PKW(pB0,12),PKW(pB0,14)};pw2=(u32x4){PKW(pB1,0),PKW(pB1,2),PKW(pB1,4),PKW(pB1,6)};pw3=(u32x4){PKW(pB1,8),PKW(pB1,10),PKW(pB1,12),PKW(pB1,14)};
    SBAR(); const int vb0=(int)(lds0+LDS_V)+((lane>>4)&1)*32+(lane&3)*8+(4*hi+((lane&15)>>2))*64; pv(o,vb0+2*sl_cur,PAF(0),PAF(1),PAF(2),PAF(3)); }
  #undef PKW
  #undef PAF
  #undef VFQ
  #undef MFB
  #undef PIN
  #undef MX3
  #undef GAPA
  #undef GAPB
  #undef EX
  #undef VRN
  #undef KRD
  #undef STEP
  #undef ENDW
  {auto rr=__builtin_amdgcn_permlane32_swap(__float_as_uint(l_reg),__float_as_uint(l_reg),false,false);l_reg=__uint_as_float(rr[0])+__uint_as_float(rr[1]);}
  if(hi==0)wsf[32+r32]=l_reg;asm volatile("s_waitcnt lgkmcnt(0)":::"memory");
  float rli[16];
  #pragma unroll
  for(int r=0;r<16;++r)rli[r]=__builtin_amdgcn_rcpf(wsf[32+crow(r,hi)]);
  bf16*Ow=O+(rowbase+q0+wid*QBLK)*DM+vcol;
  { bf16*stg=(bf16*)(shm+LDS_OST)+wid*4096;
    #pragma unroll
    for(int r=0;r<16;++r){const int orow=crow(r,hi);
      #pragma unroll
      for(int d0=0;d0<4;++d0)stg[orow*128+d0*32+r32]=__float2bfloat16(o[d0][r]*rli[r]);}
    asm volatile("s_waitcnt lgkmcnt(0)":::"memory");
    const int ch=lane&15;
    if(MODE==0){
      #pragma unroll
      for(int i=0;i<8;++i){const int row=i*4+(lane>>4); const u32x4 v=*(const u32x4*)(stg+row*128+ch*8); ATTN_STORE16(Ow+(long)row*DM+ch*8,v);} }
    else{ const long off0=(long)(Ow-O)+(long)(lane>>4)*DM+ch*8;
      u32x4 v1[8],zw[8];
      #pragma unroll
      for(int i=0;i<8;++i){ v1[i]=*(const u32x4*)(O+off0+(long)i*4*DM); zw[i]=*(const u32x4*)(ca.ZG+off0+(long)i*4*DM); }
      const pg8::f32x4 g0=*(const pg8::f32x4*)(ca.subg+ch*8), g1=*(const pg8::f32x4*)(ca.subg+ch*8+4);
      #define BLO(w) __uint_as_float((w)<<16)
      #define BHI(w) __uint_as_float((w)&0xffff0000u)
      #pragma unroll
      for(int i=0;i<8;++i){ const int row=i*4+(lane>>4); const u32x4 v=*(const u32x4*)(stg+row*128+ch*8);
        float oo[8];
        oo[0]=BLO(v1[i].x)-ca.lam*BLO(v.x); oo[1]=BHI(v1[i].x)-ca.lam*BHI(v.x); oo[2]=BLO(v1[i].y)-ca.lam*BLO(v.y); oo[3]=BHI(v1[i].y)-ca.lam*BHI(v.y);
        oo[4]=BLO(v1[i].z)-ca.lam*BLO(v.z); oo[5]=BHI(v1[i].z)-ca.lam*BHI(v.z); oo[6]=BLO(v1[i].w)-ca.lam*BLO(v.w); oo[7]=BHI(v1[i].w)-ca.lam*BHI(v.w);
        float ss=(oo[0]*oo[0]+oo[1]*oo[1])+(oo[2]*oo[2]+oo[3]*oo[3])+(oo[4]*oo[4]+oo[5]*oo[5])+(oo[6]*oo[6]+oo[7]*oo[7]);
        ss+=__shfl_xor(ss,1); ss+=__shfl_xor(ss,2); ss+=__shfl_xor(ss,4); ss+=__shfl_xor(ss,8);
        const float ri=ca.oml/sqrtf(ss*(1.0f/128.0f)+1e-5f);
        u32x4 w; w.x=cvtpk_s(oo[0]*ri*g0[0]*BLO(zw[i].x),oo[1]*ri*g0[1]*BHI(zw[i].x)); w.y=cvtpk_s(oo[2]*ri*g0[2]*BLO(zw[i].y),oo[3]*ri*g0[3]*BHI(zw[i].y));
        w.z=cvtpk_s(oo[4]*ri*g1[0]*BLO(zw[i].z),oo[5]*ri*g1[1]*BHI(zw[i].z)); w.w=cvtpk_s(oo[6]*ri*g1[2]*BLO(zw[i].w),oo[7]*ri*g1[3]*BHI(zw[i].w));
        ATTN_STORE16(ca.A2+off0+(long)i*4*DM,w); }
      #undef BLO
      #undef BHI
    } }
  asm volatile("s_waitcnt lgkmcnt(0)\n\ts_barrier":::"memory");
  #undef QLD
  #undef DMA_K
  #undef DMA_V
  #undef CMASK
  #undef START
  #undef RESC
  #undef ROT
}
constexpr int ATTN_LDS_BYTES=LDS_BYTES;
struct AttnTensors { const bf16* Q; const bf16* K; const bf16* V; bf16* O1; };
struct AttnUnit { int b, h, qb; };
struct StaticOrder {
  int vcu, G;
  __device__ __forceinline__ explicit StaticOrder(int grid,int block):vcu((grid%8==0)?(block%8)*(grid/8)+block/8:block),G(grid){}
  __device__ __forceinline__ bool next(int i,AttnUnit&u)const{ const int r=i>>2,k=i&3; const int qd=vcu+G*r; if(qd>=256)return false; const int s=qd&7,bh=qd>>3;
    u.h=bh&7; u.b=bh>>3; u.qb=(k==0)?s:(k==1)?15-s:(k==2)?16+s:31-s; return true; }
  __device__ __forceinline__ void a_ready(const AttnUnit&)const{}
  __device__ __forceinline__ void done(const AttnUnit&)const{}
};
template<class Sched,int THRL=8> __device__ __forceinline__ void attn_phase(const int wv,char*lds,const AttnTensors&T,const Comb&ca,const Sched&S){
  AttnUnit u;
  for(int i2=0;S.next(i2>>1,u);++i2){ const int w=i2&1;
    attn_unit<THRL>(w,wv,u.b,2*u.h+w,u.h*128,u.qb,T.Q,T.K,T.V,T.O1,lds,ca); }
}
#undef SBAR
#undef WAIT_BAR
}
namespace cg = cooperative_groups;
#ifndef CFG_DUMB_MASK
#define CFG_DUMB_MASK 0
#endif
#ifndef CFG_SINGLE
#define CFG_SINGLE 1
#endif
constexpr int NWAVES = 8;
constexpr int BATCH = 4, T = 8192, D = 1024, M = BATCH * T;
constexpr int SSM_L = 32, NCH = T / SSM_L, KU = 16 * SSM_L;
constexpr float NORM_EPS = 1e-6f, SUBLN_EPS = 1e-5f;
constexpr float LAM_INIT = 0.35550906759096924f;
constexpr float QSCALE = 0.125f * 1.4426950408889634f;
constexpr int NPHASE = 10;

constexpr size_t MiB = 1u << 20;
constexpr size_t WS_CTL = 0;
constexpr size_t WS_WIN = 2 * MiB, WS_WGLU = 6 * MiB, WS_WOUT = 8 * MiB, WS_WKVQ = 10 * MiB, WS_WBO = 18 * MiB;
constexpr size_t WS_TAB = 20 * MiB, TAB_STRIDE = 286720;
constexpr size_t TAB_BPT = 0, TAB_CPT = 131072, TAB_KT = 262144, TAB_AL = 279040;
constexpr size_t WS_ROPE = 38 * MiB;
constexpr size_t WS_RINV0 = 39 * MiB, WS_LAM = 39 * MiB + 256 * 1024;
constexpr size_t WS_PSS1 = 40 * MiB, WS_PSS2 = 42 * MiB;
constexpr size_t WS_E = 48 * MiB, WS_XP = 80 * MiB;
constexpr size_t WS_S0 = 128 * MiB, WS_S1 = 192 * MiB, WS_S2 = 256 * MiB, WS_S3 = 320 * MiB, WS_S4 = 384 * MiB, WS_S5 = 448 * MiB, WS_END = 512 * MiB;
static_assert(WS_TAB + 64 * TAB_STRIDE <= WS_ROPE && WS_E + (size_t)256 * NCH * 128 * 4 <= WS_XP && WS_XP + (size_t)256 * NCH * 128 * 2 <= WS_S0, "ws map");
constexpr int LDS_BYTES = 147456, MISC_OFF = LDS_BYTES - 64;
static_assert(attn_body::ATTN_LDS_BYTES <= LDS_BYTES && pg8::STAGE_BYTES <= LDS_BYTES, "LDS map");

#define LAS __attribute__((address_space(3)))
typedef unsigned short bf16;
typedef unsigned v4u __attribute__((ext_vector_type(4)));
typedef float f32x4 __attribute__((ext_vector_type(4)));
typedef float f32x16 __attribute__((ext_vector_type(16)));
typedef short bf16x8 __attribute__((ext_vector_type(8)));
__device__ __forceinline__ unsigned f2bf(float f) { unsigned u = __builtin_bit_cast(unsigned, f); return (u + 0x7fffu + ((u >> 16) & 1u)) >> 16; }
__device__ __forceinline__ unsigned pk2(float lo, float hi) { return f2bf(lo) | (f2bf(hi) << 16); }
__device__ __forceinline__ float bf2f(bf16 v) { return __uint_as_float((unsigned)v << 16); }
__device__ __forceinline__ float wave_sum(float v) {
#pragma unroll
    for (int o = 1; o < 64; o <<= 1) v += __shfl_xor(v, o);
    return v;
}
__device__ __forceinline__ float gelu_erf(float v) { return 0.5f * v * (1.0f + erff(v * 0.70710678118654752f)); }
typedef float f32x2 __attribute__((ext_vector_type(2)));
__device__ __forceinline__ f32x2 gelu_pk(f32x2 v) {
    const f32x2 av = __builtin_elementwise_abs(v), d = av * 0.2316418882f + 1.0f;
    f32x2 t; t.x = __builtin_amdgcn_rcpf(d.x); t.y = __builtin_amdgcn_rcpf(d.y);
    f32x2 q = t * 0.5307027145f + (-0.7265760135f); q = q * t + 0.7107068705f; q = q * t + (-0.142248368f); q = q * t + 0.127414796f; q = q * t;
    const f32x2 s = (v * v) * (-0.72134752044f);
    f32x2 e; e.x = __builtin_amdgcn_exp2f(s.x); e.y = __builtin_amdgcn_exp2f(s.y);
    const f32x2 m = v * (q * e), r = v - m;
    f32x2 o; o.x = v.x < 0.f ? m.x : r.x; o.y = v.y < 0.f ? m.y : r.y; return o;
}
__device__ __forceinline__ int crow(int r, int hi) { return (r & 3) + 8 * (r >> 2) + 4 * hi; }

#define RLX_AGENT __ATOMIC_RELAXED, __HIP_MEMORY_SCOPE_AGENT
#define XB_TMO      128
#define XB_XCNT(j)  (256  + 64 * (j))
#define XB_XSUB(j)  (1280 + 64 * (j))
#define XB_XGEN(j)  (2304 + 64 * (j))
#define XB_TOP      3328
#define XB_TOPGEN   3392
#define XCD_BAR_WORDS 3456
#define XB_SPIN_CAP (1u << 22)

__device__ __forceinline__ unsigned xb_ld(unsigned* p)              { return __hip_atomic_load(p, __ATOMIC_RELAXED, __HIP_MEMORY_SCOPE_AGENT); }
__device__ __forceinline__ unsigned xb_add(unsigned* p, unsigned v) { return __hip_atomic_fetch_add(p, v, __ATOMIC_RELAXED, __HIP_MEMORY_SCOPE_AGENT); }
__device__ __forceinline__ unsigned xb_xcc_id() { return (unsigned)__builtin_amdgcn_s_getreg((3 << 11) | 20) & 0xFu; }
#define XB_SPIN(cond, bar) do { unsigned _sp = 0; while (cond) { __builtin_amdgcn_s_sleep(1); \
    if ((++_sp & 255u) == 0u) { if (xb_ld(&(bar)[XB_TMO])) break; if (_sp > XB_SPIN_CAP) { atomicAdd(&(bar)[XB_TMO], 1u); break; } } } } while (0)

struct XcdBarrier {
    unsigned* bar; unsigned x;
    volatile LAS unsigned* st;
};

__device__ __forceinline__ XcdBarrier xcd_barrier_post(unsigned* bar, volatile LAS unsigned* st, const bool t0) {
    XcdBarrier b; b.bar = bar; b.x = xb_xcc_id(); b.st = st;
    if (t0) (void)xb_add(&bar[XB_XCNT(b.x)], 1u);
    return b;
}
__device__ __forceinline__ void xcd_barrier_complete(unsigned* bar, unsigned x, unsigned& nloc, unsigned& nx) {
    const unsigned G = gridDim.x * gridDim.y * gridDim.z;
    unsigned sum, cnt, mine, sp = 0u;
    for (;;) {
        sum = 0u; cnt = 0u; mine = 0u;
#pragma unroll
        for (unsigned j = 0; j < 16; ++j) { const unsigned c = xb_ld(&bar[XB_XCNT(j)]); sum += c; cnt += (c > 0u) ? 1u : 0u; mine = (j == x) ? c : mine; }
        if (sum == G) break;
        __builtin_amdgcn_s_sleep(1);
        if ((++sp & 255u) == 0u) { if (xb_ld(&bar[XB_TMO])) break; if (sp > XB_SPIN_CAP) { atomicAdd(&bar[XB_TMO], 1u); break; } }
    }
    nloc = mine > 0u ? mine : 1u; nx = cnt > 0u ? cnt : 1u;
}

__device__ __forceinline__ void xcd_barrier(const XcdBarrier& b, const bool t0) {
    asm volatile("s_waitcnt vmcnt(0)" ::: "memory");
    __syncthreads();
    if (t0) {
        unsigned* bar = b.bar;
        __builtin_amdgcn_s_waitcnt(0);
        unsigned nloc = b.st[0], nx = b.st[1];
        if (nloc == 0u) { xcd_barrier_complete(bar, b.x, nloc, nx); b.st[0] = nloc; b.st[1] = nx; }
        const unsigned old = xb_add(&bar[XB_XSUB(b.x)], 1u);
        const unsigned gen = old / nloc;
        if (old + 1u == (gen + 1u) * nloc) {
            __builtin_amdgcn_fence(__ATOMIC_RELEASE, "agent");
            asm volatile("s_waitcnt vmcnt(0)" ::: "memory");
            const unsigned og = xb_add(&bar[XB_TOP], 1u);
            const unsigned tg = og / nx;
            if (og + 1u == (tg + 1u) * nx) xb_add(&bar[XB_TOPGEN], 1u);
            else XB_SPIN(xb_ld(&bar[XB_TOPGEN]) == tg, bar);
            __builtin_amdgcn_fence(__ATOMIC_ACQUIRE, "agent");
            xb_add(&bar[XB_XGEN(b.x)], 1u);
            asm volatile("s_waitcnt vmcnt(0)" ::: "memory");
        } else {
            XB_SPIN(xb_ld(&bar[XB_XGEN(b.x)]) == gen, bar);
            __builtin_amdgcn_fence(__ATOMIC_ACQUIRE, "agent");
            asm volatile("s_waitcnt vmcnt(0)" ::: "memory");
        }
    }
    __syncthreads();
}

struct Args { const float* in[25]; float* out; unsigned char* ws; int ph_lo, ph_hi; };
enum { I_X = 0, I_ANG, I_AINW, I_LRE, I_LIM, I_LOGDT, I_BRE, I_BIM, I_CRE, I_CIM, I_AD, I_GLUW, I_GLUB, I_AOUTW, I_KVG, I_KVW, I_BNG, I_BINW, I_LQ1, I_LK1, I_LQ2, I_LK2, I_SUBG, I_BOUTW, I_FG };

__device__ __forceinline__ void p0_transpose_item(const float* W, const float* gain, int K, int N, bf16* WT, int row_off, LAS float* scr, int item, int lane) {
    const int nblk = N / 32, kb = item / nblk, nb = item % nblk, k0 = 64 * kb, n0 = 32 * nb;
    float wv_[32];
#pragma unroll
    for (int i = 0; i < 32; ++i) wv_[i] = W[(size_t)(k0 + 2 * i + (lane >> 5)) * N + n0 + (lane & 31)];
    const float g0_ = gain ? gain[k0 + lane] : 1.0f;
#pragma unroll
    for (int i = 0; i < 32; ++i) { const int kk = 2 * i + (lane >> 5); const float gk = __shfl(g0_, kk); scr[kk * 33 + (lane & 31)] = gk * wv_[i]; }
    asm volatile("s_waitcnt lgkmcnt(0)" ::: "memory");
    const int c = lane & 7;
#pragma unroll
    for (int j = 0; j < 4; ++j) { const int n = (lane >> 3) + 8 * j; const LAS float* s = scr + (8 * c) * 33 + n;
        v4u o; o.x = pk2(s[0 * 33], s[1 * 33]); o.y = pk2(s[2 * 33], s[3 * 33]); o.z = pk2(s[4 * 33], s[5 * 33]); o.w = pk2(s[6 * 33], s[7 * 33]);
        *(v4u*)(WT + (size_t)(row_off + n0 + n) * K + k0 + 8 * c) = o; }
    asm volatile("s_waitcnt lgkmcnt(0)" ::: "memory");
}
__device__ __forceinline__ void p0_ssm_tables(const int wv, const Args& a, unsigned char* ws, LAS unsigned char* lds, int g, int qd) {
    const int tid = wv * 64 + pg8::lane_id();
    LAS float* pwr = (LAS float*)lds;
    LAS float* pwi = pwr + 33 * 64;
    LAS float* bbr = pwi + 33 * 64;
    LAS float* bbi = bbr + 1024;
    LAS float* ccr = bbi + 1024;
    LAS float* cci = ccr + 1024;
    const float* lam_re = a.in[I_LRE]; const float* lam_im = a.in[I_LIM]; const float* log_dt = a.in[I_LOGDT];
    const float dt = expf(log_dt[g]);
    { const int p = tid & 63; const float lr = lam_re[g * 64 + p], li = lam_im[g * 64 + p];
      for (int tau = tid >> 6; tau <= SSM_L; tau += 8) { const float mg = expf(lr * dt * (float)tau), an = li * dt * (float)tau; pwr[tau * 64 + p] = mg * cosf(an); pwi[tau * 64 + p] = mg * sinf(an); }
      const float mg = expf(lr * dt), an = li * dt, ar = mg * cosf(an), ai = mg * sinf(an);
      const float den = lr * lr + li * li, nr = ar - 1.0f, ni = ai, fr = (nr * lr + ni * li) / den, fi = (ni * lr - nr * li) / den;
      for (int j = tid >> 6; j < 16; j += 8) { const float br = a.in[I_BRE][(size_t)(g * 64 + p) * 16 + j], bi = a.in[I_BIM][(size_t)(g * 64 + p) * 16 + j]; bbr[p * 16 + j] = fr * br - fi * bi; bbi[p * 16 + j] = fr * bi + fi * br; }
      for (int i = tid >> 6; i < 16; i += 8) { ccr[i * 64 + p] = a.in[I_CRE][(size_t)(g * 16 + i) * 64 + p]; cci[i * 64 + p] = a.in[I_CIM][(size_t)(g * 16 + i) * 64 + p]; }
    }
    __syncthreads();
    unsigned char* tg = ws + WS_TAB + (size_t)g * TAB_STRIDE;
    bf16* bpt = (bf16*)(tg + TAB_BPT); bf16* cpt = (bf16*)(tg + TAB_CPT); bf16* kt = (bf16*)(tg + TAB_KT); float* al = (float*)(tg + TAB_AL);
    for (int e = qd * 16384 + tid; e < (qd + 1) * 16384; e += 512) { const int pp = e / KU, sj = e % KU, s = sj >> 4, j = sj & 15, p = pp & 63, tau = SSM_L - 1 - s;
        const float wr = pwr[tau * 64 + p], wi = pwi[tau * 64 + p], br = bbr[p * 16 + j], bi = bbi[p * 16 + j];
        bpt[e] = (bf16)f2bf(pp < 64 ? wr * br - wi * bi : wr * bi + wi * br); }
    for (int e = qd * 16384 + tid; e < (qd + 1) * 16384; e += 512) { const int ti = e >> 7, pp = e & 127, t = ti >> 4, i = ti & 15, p = pp & 63;
        const float wr = pwr[(t + 1) * 64 + p], wi = pwi[(t + 1) * 64 + p], cr = ccr[i * 64 + p], ci = cci[i * 64 + p];
        cpt[e] = (bf16)f2bf(pp < 64 ? cr * wr - ci * wi : -(cr * wi + ci * wr)); }
    for (int e = qd * 2112 + tid; e < (qd + 1) * 2112; e += 512) { const int t1 = e >> 8, rest = e & 255, hi = rest >> 7, i = (rest & 127) >> 3, j = hi * 8 + (rest & 7);
        float s = 0.f;
        if (t1 > 0) { const int tau = t1 - 1;
            for (int p = 0; p < 64; ++p) { const float wr = pwr[tau * 64 + p], wi = pwi[tau * 64 + p], br = bbr[p * 16 + j], bi = bbi[p * 16 + j];
                s += ccr[i * 64 + p] * (wr * br - wi * bi) - cci[i * 64 + p] * (wr * bi + wi * br); } }
        if (t1 == 1 && i == j) s += a.in[I_AD][g * 16 + i];
        kt[e] = (bf16)f2bf(s); }
    if (qd == 0 && tid < 128) al[tid] = tid < 64 ? pwr[SSM_L * 64 + tid] : pwi[SSM_L * 64 + tid - 64];
    __syncthreads();
}

__device__ __forceinline__ void ssm_phase(LAS unsigned char* lds, const bf16* U, bf16* YG, const unsigned char* tab, float* Eg, bf16* XPg, const float* dskip, int vcu, int G, const int wv) {
    const int wid = wv;
    for (int item = vcu; item < 256; item += G) {
        const int lane = pg8::lane_id_v(), tid = wv * 64 + lane, r32 = lane & 31, hi = lane >> 5;
        const int b = item >> 6, g = item & 63;
        const unsigned char* tg = tab + (size_t)g * TAB_STRIDE;
        const bf16* Ub = U + (size_t)item * T * 16;
        bf16* XP = XPg + (size_t)item * NCH * 128;
        const bf16* ua = Ub + (size_t)((wid * 32 + r32) * SSM_L) * 16 + hi * 8;
        {
            const unsigned char* gsrc = tg + TAB_BPT + (size_t)tid * 16; LAS unsigned char* ldst = lds + (tid >> 6) * 1040 + (tid & 63) * 16;
            for (int h2 = 0; h2 < 2; ++h2) { v4u tb[8];
#pragma unroll
                for (int k = 0; k < 8; ++k) tb[k] = *(const v4u*)(gsrc + k * 8192);
#pragma unroll
                for (int k = 0; k < 8; ++k) *(LAS v4u*)(ldst + k * 8320) = tb[k];
                gsrc += 65536; ldst += 8 * 8320; } }
        __syncthreads();
        {
            f32x16 acc[4];
#pragma unroll
            for (int n = 0; n < 4; ++n) acc[n] = f32x16{};
            const LAS unsigned char* bb = lds + r32 * 1040 + hi * 16;
            bf16x8 uc[8];
#pragma unroll
            for (int j = 0; j < 8; ++j) uc[j] = *(const bf16x8*)(ua + (size_t)j * 16);
            for (int bt = 0; bt < 4; ++bt) {
                bf16x8 un[8];
                if (bt < 3) {
#pragma unroll
                    for (int j = 0; j < 8; ++j) un[j] = *(const bf16x8*)(ua + (size_t)(8 * bt + 8 + j) * 16); }
                const LAS unsigned char* bq = bb + bt * 256;
                bf16x8 bc[4], bn[4];
#pragma unroll
                for (int n = 0; n < 4; ++n) bc[n] = *(const LAS bf16x8*)(bq + n * 32 * 1040);
#pragma unroll
                for (int j = 0; j < 8; ++j) {
                    if (j < 7) {
#pragma unroll
                        for (int n = 0; n < 4; ++n) bn[n] = *(const LAS bf16x8*)(bq + n * 32 * 1040 + (j + 1) * 32); }
#pragma unroll
                    for (int n = 0; n < 4; ++n) acc[n] = __builtin_amdgcn_mfma_f32_32x32x16_bf16(uc[j], bc[n], acc[n], 0, 0, 0);
                    if (j < 7) {
#pragma unroll
                        for (int n = 0; n < 4; ++n) bc[n] = bn[n]; }
                }
                if (bt < 3) {
#pragma unroll
                    for (int j = 0; j < 8; ++j) uc[j] = un[j]; }
            }
            __syncthreads();
            LAS float* El = (LAS float*)lds;
#pragma unroll
            for (int n = 0; n < 4; ++n)
#pragma unroll
                for (int r = 0; r < 16; ++r) El[(wid * 32 + crow(r, hi)) * 128 + n * 32 + r32] = acc[n][r];
        }
        __syncthreads();
        {
            const float* al = (const float*)(tg + TAB_AL); const float ar = al[lane], ai = al[64 + lane];
            const LAS float* ep = (const LAS float*)lds + (wid * 32) * 128 + lane;
            float xr = 0.f, xi = 0.f;
            for (int kb = 0; kb < 4; ++kb) { float er[8], ei[8];
#pragma unroll
                for (int k = 0; k < 8; ++k) { er[k] = ep[k * 128]; ei[k] = ep[k * 128 + 64]; }
#pragma unroll
                for (int k = 0; k < 8; ++k) { const float nr = ar * xr - ai * xi + er[k], ni = ar * xi + ai * xr + ei[k]; xr = nr; xi = ni; }
                ep += 8 * 128; }
            LAS float* sg = (LAS float*)(lds + 131072);
            sg[(wid * 64 + lane) * 2] = xr; sg[(wid * 64 + lane) * 2 + 1] = xi;
            __syncthreads();
            float pr = ar, pi = ai;
#pragma unroll
            for (int k = 0; k < 5; ++k) { const float nr = pr * pr - pi * pi, ni = 2.0f * pr * pi; pr = nr; pi = ni; }
            float sr = 0.f, si = 0.f;
            for (int s2 = 0; s2 < wid; ++s2) { const float zr = sg[(s2 * 64 + lane) * 2], zi = sg[(s2 * 64 + lane) * 2 + 1]; const float nr = pr * sr - pi * si + zr, ni = pr * si + pi * sr + zi; sr = nr; si = ni; }
            xr = sr; xi = si;
            ep = (const LAS float*)lds + (wid * 32) * 128 + lane; bf16* xp = XP + (size_t)(wid * 32) * 128 + lane;
            for (int kb = 0; kb < 4; ++kb) { float er[8], ei[8];
#pragma unroll
                for (int k = 0; k < 8; ++k) { er[k] = ep[k * 128]; ei[k] = ep[k * 128 + 64]; }
#pragma unroll
                for (int k = 0; k < 8; ++k) { xp[k * 128] = (bf16)f2bf(xr); xp[k * 128 + 64] = (bf16)f2bf(xi);
                    const float nr = ar * xr - ai * xi + er[k], ni = ar * xi + ai * xr + ei[k]; xr = nr; xi = ni; }
                ep += 8 * 128; xp += 8 * 128; }
        }
        __syncthreads();
        constexpr int KT_LDS = 256 * 272;
        for (int half = 0; half < 2; ++half) {
            {   v4u tb[8], tk[3];
                const unsigned char* gsrc = tg + TAB_CPT + (size_t)half * 65536 + (size_t)tid * 16; LAS unsigned char* ldst = lds + (tid >> 4) * 272 + (tid & 15) * 16;
                const unsigned char* ksrc = tg + TAB_KT + (size_t)tid * 16; LAS unsigned char* kdst = lds + KT_LDS + tid * 16;
#pragma unroll
                for (int k = 0; k < 8; ++k) tb[k] = *(const v4u*)(gsrc + k * 8192);
                if (half == 0) { tk[0] = *(const v4u*)ksrc; tk[1] = *(const v4u*)(ksrc + 8192); if (tid < 32) tk[2] = *(const v4u*)(ksrc + 16384); }
#pragma unroll
                for (int k = 0; k < 8; ++k) *(LAS v4u*)(ldst + k * 8704) = tb[k];
                if (half == 0) { *(LAS v4u*)kdst = tk[0]; *(LAS v4u*)(kdst + 8192) = tk[1]; if (tid < 32) *(LAS v4u*)(kdst + 16384) = tk[2]; } }
            __syncthreads();
            for (int qq = 0; qq < 2; ++qq) {
                const int q = half * 2 + qq;
                f32x16 acc[4];
#pragma unroll
                for (int n = 0; n < 4; ++n) acc[n] = f32x16{};
                const LAS unsigned char* kb = lds + KT_LDS + (r32 >> 4) * 512 + hi * 256 + (r32 & 15) * 16;
                const bf16* xa = XP + (size_t)(wid * 32 + r32) * 128 + hi * 8;
                const LAS unsigned char* cb = lds + (qq * 128 + r32) * 272 + hi * 16;
                bf16x8 uc[8];
#pragma unroll
                for (int j = 0; j < 8; ++j) uc[j] = *(const bf16x8*)(ua + (size_t)j * 16);
                for (int bt = 0; bt < q; ++bt) {
                    bf16x8 un[8];
#pragma unroll
                    for (int j = 0; j < 8; ++j) un[j] = *(const bf16x8*)(ua + (size_t)(8 * bt + 8 + j) * 16);
                    const LAS unsigned char* kq = kb + (8 * (q - bt) + 1) * 512;
                    bf16x8 bc[4], bn[4];
#pragma unroll
                    for (int n = 0; n < 4; ++n) bc[n] = *(const LAS bf16x8*)(kq + (2 * n) * 512);
#pragma unroll
                    for (int j = 0; j < 8; ++j) {
                        if (j < 7) {
#pragma unroll
                            for (int n = 0; n < 4; ++n) bn[n] = *(const LAS bf16x8*)(kq + (2 * n - (j + 1)) * 512); }
#pragma unroll
                        for (int n = 0; n < 4; ++n) acc[n] = __builtin_amdgcn_mfma_f32_32x32x16_bf16(bc[n], uc[j], acc[n], 0, 0, 0);
                        if (j < 7) {
#pragma unroll
                            for (int n = 0; n < 4; ++n) bc[n] = bn[n]; }
                    }
#pragma unroll
                    for (int j = 0; j < 8; ++j) uc[j] = un[j];
                }
#pragma unroll
                for (int j = 0; j < 8; ++j) {
                    bf16x8 bd[4];
#pragma unroll
                    for (int n = 0; n < 4; ++n) if (j <= 2 * n + 1) bd[n] = *(const LAS bf16x8*)(kb + (2 * n - j + 1) * 512);
#pragma unroll
                    for (int n = 0; n < 4; ++n) if (j <= 2 * n + 1) acc[n] = __builtin_amdgcn_mfma_f32_32x32x16_bf16(bd[n], uc[j], acc[n], 0, 0, 0);
                }
                {   bf16x8 bc[4], bn[4];
                    bf16x8 xv[8];
#pragma unroll
                    for (int ks = 0; ks < 8; ++ks) xv[ks] = *(const bf16x8*)(xa + ks * 16);
#pragma unroll
                    for (int n = 0; n < 4; ++n) bc[n] = *(const LAS bf16x8*)(cb + n * 32 * 272);
#pragma unroll
                    for (int ks = 0; ks < 8; ++ks) {
                        if (ks < 7) {
#pragma unroll
                            for (int n = 0; n < 4; ++n) bn[n] = *(const LAS bf16x8*)(cb + n * 32 * 272 + (ks + 1) * 32); }
#pragma unroll
                        for (int n = 0; n < 4; ++n) acc[n] = __builtin_amdgcn_mfma_f32_32x32x16_bf16(bc[n], xv[ks], acc[n], 0, 0, 0);
                        if (ks < 7) {
#pragma unroll
                            for (int n = 0; n < 4; ++n) bc[n] = bn[n]; }
                    }
                }
                const size_t rbase = ((size_t)b * T + (size_t)(wid * 32 + r32) * SSM_L) * 1024 + g * 16 + 8 * hi;
#pragma unroll
                for (int n = 0; n < 4; ++n)
#pragma unroll
                    for (int ap = 0; ap < 2; ++ap) { const int a0 = 2 * ap, a1 = 2 * ap + 1;
                        const f32x2 xa = gelu_pk((f32x2){acc[n][4 * a0 + 0], acc[n][4 * a0 + 1]}), xb = gelu_pk((f32x2){acc[n][4 * a0 + 2], acc[n][4 * a0 + 3]});
                        const f32x2 ya = gelu_pk((f32x2){acc[n][4 * a1 + 0], acc[n][4 * a1 + 1]}), yb = gelu_pk((f32x2){acc[n][4 * a1 + 2], acc[n][4 * a1 + 3]});
                        const auto r0 = __builtin_amdgcn_permlane32_swap(pk2(xa.x, xa.y), pk2(ya.x, ya.y), false, false);
                        const auto r1 = __builtin_amdgcn_permlane32_swap(pk2(xb.x, xb.y), pk2(yb.x, yb.y), false, false);
                        v4u w; w.x = r0[0]; w.y = r1[0]; w.z = r0[1]; w.w = r1[1];
                        *(v4u*)(YG + rbase + (size_t)(8 * q + 2 * n + ap) * 1024) = w; }
            }
            __syncthreads();
        }
    }
}

struct DumbEpi { int kind; int pad; bf16 *o0, *o1, *o2, *o3; const bf16 *i0, *i1; const float* f0; const float* f1; float* fo; };
__device__ __forceinline__ float pss_rinv(const float* PSS, int row) { float s = 0.f; for (int k = 0; k < 16; ++k) s += PSS[(size_t)row * 16 + k]; return 1.0f / sqrtf(s * (1.0f / 1024.0f) + NORM_EPS); }
__device__ __forceinline__ void dumb_epi(const DumbEpi& e, int row, int col, float v) {
    const size_t off = (size_t)row * 1024;
    if (e.kind == 1) { v *= e.f0[row]; if (col < 1024) e.o0[off + col] = (bf16)f2bf(v); else e.o1[off + col - 1024] = (bf16)f2bf(pg8::silu_f(v)); }
    else if (e.kind == 3) { const float t = v + e.f0[col]; e.o0[off + col] = (bf16)f2bf(bf2f(e.i0[off + col]) * pg8::sigm_f(t) * bf2f(e.i1[off + col])); }
    else if (e.kind == 4) { const float h = e.f0[off + col] + v; e.fo[off + col] = h; if (e.o0) e.o0[off + col] = (bf16)f2bf(h); }
    else if (e.kind == 5) { v *= pss_rinv(e.f0, row); const int seg = col >> 10, c = col & 1023;
        if (seg == 0) e.o0[off + c] = (bf16)f2bf(v); else if (seg == 1) e.o1[off + c] = (bf16)f2bf(v); else if (seg == 2) e.o2[off + c] = (bf16)f2bf(v * QSCALE); else e.o3[off + c] = (bf16)f2bf(pg8::silu_f(v)); }
}
__global__ void __launch_bounds__(256) dumb_gemm(const bf16* A, const bf16* Bt, int N, int K, DumbEpi e) {
    __shared__ float As[32][65], Bs[32][65];
    const int tid = threadIdx.x, tx = tid & 15, ty = tid >> 4, m0 = blockIdx.y * 64, n0 = blockIdx.x * 64;
    float acc[4][4];
#pragma unroll
    for (int i = 0; i < 4; ++i)
#pragma unroll
        for (int j = 0; j < 4; ++j) acc[i][j] = 0.f;
    const int lr = tid >> 2, lk = (tid & 3) * 8;
    for (int k0 = 0; k0 < K; k0 += 32) {
        const v4u av = *(const v4u*)(A + (size_t)(m0 + lr) * K + k0 + lk), bv = *(const v4u*)(Bt + (size_t)(n0 + lr) * K + k0 + lk);
        As[lk + 0][lr] = pg8::bf_lo(av.x); As[lk + 1][lr] = pg8::bf_hi(av.x); As[lk + 2][lr] = pg8::bf_lo(av.y); As[lk + 3][lr] = pg8::bf_hi(av.y);
        As[lk + 4][lr] = pg8::bf_lo(av.z); As[lk + 5][lr] = pg8::bf_hi(av.z); As[lk + 6][lr] = pg8::bf_lo(av.w); As[lk + 7][lr] = pg8::bf_hi(av.w);
        Bs[lk + 0][lr] = pg8::bf_lo(bv.x); Bs[lk + 1][lr] = pg8::bf_hi(bv.x); Bs[lk + 2][lr] = pg8::bf_lo(bv.y); Bs[lk + 3][lr] = pg8::bf_hi(bv.y);
        Bs[lk + 4][lr] = pg8::bf_lo(bv.z); Bs[lk + 5][lr] = pg8::bf_hi(bv.z); Bs[lk + 6][lr] = pg8::bf_lo(bv.w); Bs[lk + 7][lr] = pg8::bf_hi(bv.w);
        __syncthreads();
#pragma unroll 8
        for (int kk = 0; kk < 32; ++kk) { float a[4], b[4];
#pragma unroll
            for (int i = 0; i < 4; ++i) { a[i] = As[kk][ty * 4 + i]; b[i] = Bs[kk][tx * 4 + i]; }
#pragma unroll
            for (int i = 0; i < 4; ++i)
#pragma unroll
                for (int j = 0; j < 4; ++j) acc[i][j] += a[i] * b[j]; }
        __syncthreads();
    }
#pragma unroll
    for (int i = 0; i < 4; ++i)
#pragma unroll
        for (int j = 0; j < 4; ++j) dumb_epi(e, m0 + ty * 4 + i, n0 + tx * 4 + j, acc[i][j]);
}
__global__ void __launch_bounds__(256) dumb_rowss(const float* H, float* PSS) {
    const int row = blockIdx.x * 4 + (threadIdx.x >> 6), lane = threadIdx.x & 63; float s = 0.f;
    for (int c = lane; c < 1024; c += 64) { const float v = H[(size_t)row * 1024 + c]; s += v * v; }
    s = wave_sum(s); if (lane < 16) PSS[(size_t)row * 16 + lane] = lane == 0 ? s : 0.f;
}
__global__ void __launch_bounds__(256) dumb_rope(bf16* X, const float* rc, const float* rs) {
    const size_t idx = (size_t)blockIdx.x * 256 + threadIdx.x;
    const int i = idx & 7, h = (idx >> 3) & 15; const size_t row = idx >> 7; const int pos = (int)(row & 8191);
    bf16* p = X + row * 1024 + h * 64 + i; const float x1 = bf2f(p[0]), x2 = bf2f(p[8]), c = rc[pos * 8 + i], s = rs[pos * 8 + i];
    p[0] = (bf16)f2bf(x1 * c - x2 * s); p[8] = (bf16)f2bf(x2 * c + x1 * s);
}
__global__ void __launch_bounds__(64) dumb_ssm(const bf16* U, bf16* YG, const float* lam_re, const float* lam_im, const float* log_dt, const float* b_re, const float* b_im,
                                               const float* c_re, const float* c_im, const float* d_skip) {
    const int item = blockIdx.x, b = item >> 6, g = item & 63, p = threadIdx.x;
    const float dt = expf(log_dt[g]), lr = lam_re[g * 64 + p], li = lam_im[g * 64 + p];
    const float mg = expf(lr * dt), an = li * dt, ar = mg * cosf(an), ai = mg * sinf(an);
    const float den = lr * lr + li * li, nr = ar - 1.0f, ni = ai, fr = (nr * lr + ni * li) / den, fi = (ni * lr - nr * li) / den;
    float bbr[16], bbi[16], cr[16], ci[16];
#pragma unroll
    for (int j = 0; j < 16; ++j) { const float br = b_re[(size_t)(g * 64 + p) * 16 + j], bi = b_im[(size_t)(g * 64 + p) * 16 + j]; bbr[j] = fr * br - fi * bi; bbi[j] = fr * bi + fi * br;
        cr[j] = c_re[(size_t)(g * 16 + j) * 64 + p]; ci[j] = c_im[(size_t)(g * 16 + j) * 64 + p]; }
    const float dv = d_skip[g * 16 + (p & 15)];
    float xr = 0.f, xi = 0.f;
    for (int t = 0; t < T; ++t) {
        const bf16* up = U + ((size_t)b * T + t) * 1024 + g * 16;
        const v4u w0 = *(const v4u*)up, w1 = *(const v4u*)(up + 8);
        float uu[16];
        uu[0] = pg8::bf_lo(w0.x); uu[1] = pg8::bf_hi(w0.x); uu[2] = pg8::bf_lo(w0.y); uu[3] = pg8::bf_hi(w0.y); uu[4] = pg8::bf_lo(w0.z); uu[5] = pg8::bf_hi(w0.z); uu[6] = pg8::bf_lo(w0.w); uu[7] = pg8::bf_hi(w0.w);
        uu[8] = pg8::bf_lo(w1.x); uu[9] = pg8::bf_hi(w1.x); uu[10] = pg8::bf_lo(w1.y); uu[11] = pg8::bf_hi(w1.y); uu[12] = pg8::bf_lo(w1.z); uu[13] = pg8::bf_hi(w1.z); uu[14] = pg8::bf_lo(w1.w); uu[15] = pg8::bf_hi(w1.w);
        float bur = 0.f, bui = 0.f;
#pragma unroll
        for (int j = 0; j < 16; ++j) { bur += bbr[j] * uu[j]; bui += bbi[j] * uu[j]; }
        const float n_r = ar * xr - ai * xi + bur, n_i = ar * xi + ai * xr + bui; xr = n_r; xi = n_i;
        float myy = 0.f;
#pragma unroll
        for (int i = 0; i < 16; ++i) { const float s = wave_sum(cr[i] * xr - ci[i] * xi); if (p == i) myy = s; }
        if (p < 16) { const float y = myy + dv * bf2f(up[p]); YG[((size_t)b * T + t) * 1024 + g * 16 + p] = (bf16)f2bf(gelu_erf(y)); }
    }
}
__global__ void __launch_bounds__(128) dumb_attn(const bf16* Q, const bf16* K, const bf16* V, bf16* O1, bf16* O2) {
    __shared__ float sc[T]; __shared__ float red[2]; __shared__ float qs[64];
    const int q = blockIdx.x, vh = blockIdx.y, b = blockIdx.z, t = threadIdx.x, lane = t & 63, w = t >> 6;
    const size_t row = (size_t)b * T + q;
    if (t < 64) qs[t] = bf2f(Q[row * 1024 + vh * 64 + t]);
    __syncthreads();
    float mx = -INFINITY;
    for (int k = t; k <= q; k += 128) { const bf16* kp = K + ((size_t)b * T + k) * 1024 + vh * 64; float s = 0.f;
        for (int d = 0; d < 64; d += 8) { const v4u kv = *(const v4u*)(kp + d);
            s += qs[d] * pg8::bf_lo(kv.x) + qs[d + 1] * pg8::bf_hi(kv.x) + qs[d + 2] * pg8::bf_lo(kv.y) + qs[d + 3] * pg8::bf_hi(kv.y) + qs[d + 4] * pg8::bf_lo(kv.z) + qs[d + 5] * pg8::bf_hi(kv.z) + qs[d + 6] * pg8::bf_lo(kv.w) + qs[d + 7] * pg8::bf_hi(kv.w); }
        sc[k] = s; mx = fmaxf(mx, s); }
#pragma unroll
    for (int o = 1; o < 64; o <<= 1) mx = fmaxf(mx, __shfl_xor(mx, o));
    if (lane == 0) red[w] = mx;
    __syncthreads();
    mx = fmaxf(red[0], red[1]);
    __syncthreads();
    float sum = 0.f;
    for (int k = t; k <= q; k += 128) { const float pv = exp2f(sc[k] - mx); sc[k] = pv; sum += pv; }
    sum = wave_sum(sum);
    if (lane == 0) red[w] = sum;
    __syncthreads();
    sum = red[0] + red[1];
    const int h = vh >> 1; float o = 0.f;
    for (int k = 0; k <= q; ++k) o += sc[k] * bf2f(V[((size_t)b * T + k) * 1024 + h * 128 + t]);
    bf16* O = (vh & 1) ? O2 : O1; O[row * 1024 + h * 128 + t] = (bf16)f2bf(o / sum);
}

__global__ void __launch_bounds__(NWAVES * 64, 2) mega(Args args) {
    extern __shared__ __attribute__((aligned(16))) unsigned char lds_raw[];
    LAS unsigned char* lds = (LAS unsigned char*)lds_raw;
    const int wave = __builtin_amdgcn_readfirstlane(threadIdx.x >> 6);
#define lane (pg8::lane_id())
#define tid (wave * 64 + pg8::lane_id())
    const int G = gridDim.x; const int bx = blockIdx.x; const int vcu = (G % 8 == 0) ? (bx % 8) * (G / 8) + bx / 8 : bx;
#define ws (args.ws)
    const int lo = args.ph_lo, hi = args.ph_hi;
    volatile LAS unsigned* MISC = (volatile LAS unsigned*)(lds + MISC_OFF);
    XcdBarrier xbar; xbar.bar = (unsigned*)(ws + WS_CTL) + 4096; xbar.x = 0; xbar.st = nullptr;
    if (lo < -1000) cg::this_grid().sync();
    if (hi - lo > 1) { if (pg8::lane_id() < 16 && wave == 0) MISC[pg8::lane_id()] = 0u; __syncthreads(); xbar = xcd_barrier_post((unsigned*)(ws + WS_CTL) + 4096, MISC + 8, wave == 0 && pg8::lane_id() == 0); }
#ifndef CFG_SKIP
#define CFG_SKIP 0
#endif
#define IN(k) (lo <= (k) && (k) < hi && !((CFG_SKIP >> (k)) & 1))
#ifndef CFG_REP_MASK
#define CFG_REP_MASK 0
#endif
#define REPS(k) (IN(k) ? 1 + ((CFG_REP_MASK >> (k)) & 1) : 0)
#define SEAM(k) do { if (IN(k) && IN((k) + 1)) { xcd_barrier(xbar, tid == 0); } } while (0)
#define WIN ((bf16*)(ws + WS_WIN))
#define WGLU ((bf16*)(ws + WS_WGLU))
#define WOUT ((bf16*)(ws + WS_WOUT))
#define WKVQ ((bf16*)(ws + WS_WKVQ))
#define WBO ((bf16*)(ws + WS_WBO))
#define ropec ((float*)(ws + WS_ROPE))
#define ropes ((float*)(ws + WS_ROPE + 256 * 1024))
#define rinv0 ((float*)(ws + WS_RINV0))
#define lamv ((float*)(ws + WS_LAM))
#define PSS1 ((float*)(ws + WS_PSS1))
#define PSS2 ((float*)(ws + WS_PSS2))
#define XB ((bf16*)(ws + WS_S0))
#define YG ((bf16*)(ws + WS_S0))
#define H1B ((bf16*)OUTP)
#define H2B ((bf16*)(ws + WS_S3))
#define O1 ((bf16*)(ws + WS_S0))
#define U ((bf16*)(ws + WS_S1))
#define Y2 ((bf16*)(ws + WS_S1))
#define KB ((bf16*)(ws + WS_S1))
#define A2 ((bf16*)(ws + WS_S5))
#define ZG ((bf16*)(ws + WS_S2))
#define VB ((bf16*)(ws + WS_S2))
#define QB ((bf16*)(ws + WS_S3))
#define ZG2 ((bf16*)(ws + WS_S4))
#define O2 ((bf16*)(ws + WS_S5))
#define XIN (args.in[I_X])
#define OUTP (args.out)
#define gw (vcu * NWAVES + wave)
#define NGW (G * NWAVES)

    for (int rep_ = 0; rep_ < REPS(0); ++rep_) {
        LAS float* scr = (LAS float*)(lds + wave * 16384);
        constexpr int I_1 = 16 * 64, I_2 = 16 * 32;
        constexpr int NITEMS = 3 * I_1 + 3 * I_2;
        for (int it = gw; it < NITEMS; it += NGW) {
            int r = it;
            if (r < I_1) { p0_transpose_item(args.in[I_AINW], args.in[I_ANG], D, 2048, WIN, 0, scr, r, lane); continue; } r -= I_1;
            if (r < I_1) { p0_transpose_item(args.in[I_KVW], args.in[I_KVG], D, 2048, WKVQ, 0, scr, r, lane); continue; } r -= I_1;
            if (r < I_1) { p0_transpose_item(args.in[I_BINW], args.in[I_BNG], D, 2048, WKVQ, 2048, scr, r, lane); continue; } r -= I_1;
            if (r < I_2) { p0_transpose_item(args.in[I_GLUW], nullptr, D, 1024, WGLU, 0, scr, r, lane); continue; } r -= I_2;
            if (r < I_2) { p0_transpose_item(args.in[I_AOUTW], nullptr, D, 1024, WOUT, 0, scr, r, lane); continue; } r -= I_2;
            p0_transpose_item(args.in[I_BOUTW], nullptr, D, 1024, WBO, 0, scr, r, lane);
        }
        for (int m0 = gw; m0 < M; m0 += 4 * NGW) {
            f32x4 v[4][4];
#pragma unroll
            for (int k = 0; k < 4; ++k) { const int m = m0 + k * NGW; if (m < M) { const f32x4* xr = (const f32x4*)(XIN + (size_t)m * D) + lane;
#pragma unroll
                for (int j = 0; j < 4; ++j) v[k][j] = xr[64 * j]; } }
#pragma unroll
            for (int k = 0; k < 4; ++k) { const int m = m0 + k * NGW; if (m < M) { float s = 0.f;
#pragma unroll
                for (int j = 0; j < 4; ++j) s += (v[k][j].x * v[k][j].x + v[k][j].y * v[k][j].y) + (v[k][j].z * v[k][j].z + v[k][j].w * v[k][j].w);
                s = wave_sum(s); if (lane == 0) rinv0[m] = 1.0f / sqrtf(s * (1.0f / D) + NORM_EPS);
                unsigned long long* o8 = (unsigned long long*)(XB + (size_t)m * D) + lane;
#pragma unroll
                for (int j = 0; j < 4; ++j) o8[64 * j] = (unsigned long long)pk2(v[k][j].x, v[k][j].y) | ((unsigned long long)pk2(v[k][j].z, v[k][j].w) << 32); } }
        }
        for (int e = vcu * 512 + tid; e < T * 8; e += G * 512) { const int pos = e >> 3, i = e & 7; const float inv = powf(500000.0f, -(float)i / 8.0f); const float an = (float)pos * inv; ropec[e] = cosf(an); ropes[e] = sinf(an); }
        if (bx == 0 && wave == 0) { const float a1 = wave_sum(args.in[I_LQ1][lane] * args.in[I_LK1][lane]), a2 = wave_sum(args.in[I_LQ2][lane] * args.in[I_LK2][lane]); if (lane == 0) lamv[0] = expf(a1) - expf(a2) + LAM_INIT; }
        __syncthreads();
        for (int it = vcu; it < 256; it += G) p0_ssm_tables(wave, args, ws, lds, it >> 2, it & 3);
    }
    SEAM(0);
    for (int rep_ = 0; rep_ < REPS(1); ++rep_) {
        pg8::Gemm g{XB, WIN, M, 2048, D}; pg8::StaticOrder S; S.init(M, 2048, G, bx);
        pg8::EpiUZ E{U, ZG, rinv0};
        pg8::gemm_phase<pg8::EpiUZ, pg8::StaticOrder, true, true>(wave, lds, g, S, E);
    }
    SEAM(1);
    for (int rep_ = 0; rep_ < REPS(2); ++rep_) ssm_phase(lds, U, YG, ws + WS_TAB, (float*)(ws + WS_E), (bf16*)(ws + WS_XP), args.in[I_AD], vcu, G, wave);
    SEAM(2);
    for (int rep_ = 0; rep_ < REPS(3); ++rep_) {
        pg8::Gemm g{YG, WGLU, M, 1024, D}; pg8::StaticOrder S; S.init(M, 1024, G, bx);
        pg8::EpiGlu E{YG, ZG, args.in[I_GLUB], Y2};
        pg8::gemm_phase<pg8::EpiGlu, pg8::StaticOrder, false, true>(wave, lds, g, S, E);
    }
    SEAM(3);
    for (int rep_ = 0; rep_ < REPS(4); ++rep_) {
        pg8::Gemm g{Y2, WOUT, M, 1024, D}; pg8::StaticOrder S; S.init(M, 1024, G, bx);
        pg8::EpiRes<false> E{XIN, H1B, PSS1};
        pg8::gemm_phase<pg8::EpiRes<false>, pg8::StaticOrder, true, true>(wave, lds, g, S, E);
    }
    SEAM(4);
    for (int rep_ = 0; rep_ < REPS(5); ++rep_) {
        pg8::Gemm g{H1B, WKVQ, M, 4096, D}; pg8::StaticOrder S; S.init(M, 4096, G, bx);
        pg8::EpiKVQZ E{KB, VB, QB, ZG2, PSS1, ropec, ropes, QSCALE};
        pg8::gemm_phase<pg8::EpiKVQZ, pg8::StaticOrder, true, true>(wave, lds, g, S, E);
    }
    SEAM(5);
    for (int rep_ = 0; rep_ < REPS(6); ++rep_) {
        const attn_body::AttnTensors AT{(const attn_body::bf16*)QB, (const attn_body::bf16*)KB, (const attn_body::bf16*)VB, (attn_body::bf16*)O1};
        const attn_body::Comb CA{(const attn_body::bf16*)ZG2, (attn_body::bf16*)A2, args.in[I_SUBG], lamv[0], 1.0f - LAM_INIT};
        const attn_body::StaticOrder S(G, bx);
        attn_body::attn_phase<attn_body::StaticOrder>(wave, (char*)lds_raw, AT, CA, S);
    }
    if (IN(6) && IN(8)) xcd_barrier(xbar, tid == 0);
    for (int rep_ = 0; rep_ < REPS(8); ++rep_) {
        pg8::Gemm g{A2, WBO, M, 1024, D}; pg8::StaticOrder S; S.init(M, 1024, G, bx);
        pg8::EpiRes<true> E{H1B, H2B, PSS2};
        pg8::gemm_phase<pg8::EpiRes<true>, pg8::StaticOrder, true, true>(wave, lds, g, S, E);
    }
    SEAM(8);
#ifndef CFG_EXTRA_SYNC
#define CFG_EXTRA_SYNC 0
#endif
    if (IN(8) && IN(9)) for (int es_ = 0; es_ < CFG_EXTRA_SYNC; ++es_) cg::this_grid().sync();
    for (int rep_ = 0; rep_ < REPS(9); ++rep_) {
        const float* fg = args.in[I_FG];
        const f32x4* gr = (const f32x4*)fg + 4 * lane; const f32x4 g0 = gr[0], g1 = gr[1], g2 = gr[2], g3 = gr[3];
        for (int m0 = gw; m0 < M; m0 += 4 * NGW) {
            v4u h0[4], h1[4]; float ps[4];
#pragma unroll
            for (int k = 0; k < 4; ++k) { const int m = m0 + k * NGW; if (m < M) { h0[k] = *((const v4u*)(H2B + (size_t)m * D) + 2 * lane); h1[k] = *((const v4u*)(H2B + (size_t)m * D) + 2 * lane + 1); ps[k] = lane < 16 ? PSS2[(size_t)m * 16 + lane] : 0.f; } }
#pragma unroll
            for (int k = 0; k < 4; ++k) { const int m = m0 + k * NGW; if (m < M) { const float ri = 1.0f / sqrtf(wave_sum(ps[k]) * (1.0f / D) + NORM_EPS);
                f32x4* orow = (f32x4*)(OUTP + (size_t)m * D) + 4 * lane;
                orow[0] = (f32x4){pg8::bf_lo(h0[k].x), pg8::bf_hi(h0[k].x), pg8::bf_lo(h0[k].y), pg8::bf_hi(h0[k].y)} * ri * g0;
                orow[1] = (f32x4){pg8::bf_lo(h0[k].z), pg8::bf_hi(h0[k].z), pg8::bf_lo(h0[k].w), pg8::bf_hi(h0[k].w)} * ri * g1;
                orow[2] = (f32x4){pg8::bf_lo(h1[k].x), pg8::bf_hi(h1[k].x), pg8::bf_lo(h1[k].y), pg8::bf_hi(h1[k].y)} * ri * g2;
                orow[3] = (f32x4){pg8::bf_lo(h1[k].z), pg8::bf_hi(h1[k].z), pg8::bf_lo(h1[k].w), pg8::bf_hi(h1[k].w)} * ri * g3; } }
        }
    }
#undef IN
#undef SEAM
#undef REPS
#undef WIN
#undef WGLU
#undef WOUT
#undef WKVQ
#undef WBO
#undef ropec
#undef ropes
#undef rinv0
#undef lamv
#undef PSS1
#undef PSS2
#undef XB
#undef YG
#undef H1B
#undef H2B
#undef O1
#undef U
#undef Y2
#undef KB
#undef A2
#undef ZG
#undef VB
#undef QB
#undef ZG2
#undef O2
#undef lane
#undef tid
#undef XIN
#undef OUTP
#undef gw
#undef NGW
#undef ws
}

static void launch_mega(int grid, Args a, int lo, int hi, bool coop, hipStream_t stream) {
    a.ph_lo = lo; a.ph_hi = hi;
    if (coop) { void* kargs[] = {&a}; hipError_t e = hipLaunchCooperativeKernel((const void*)mega, dim3(grid), dim3(NWAVES * 64), kargs, LDS_BYTES, stream);
        if (e != hipSuccess) fprintf(stderr, "kernel_launch: cooperative launch failed: %s (grid %d)\n", hipGetErrorString(e), grid); }
    else hipLaunchKernelGGL(mega, dim3(grid), dim3(NWAVES * 64), LDS_BYTES, stream, a);
}
extern "C" void kernel_launch(void* const* d_in, const int* in_sizes, int n_in, void* d_out, int out_size, void* d_ws, size_t ws_size, hipStream_t stream) {
    static int grid = 0;
    if (grid == 0) {
        if (n_in != 25 || in_sizes[0] != M * D || out_size != M * D || ws_size < WS_END) { fprintf(stderr, "kernel_launch: unexpected shapes (n_in %d, in0 %d, out %d, ws %zu); nothing launched\n", n_in, n_in > 0 ? in_sizes[0] : -1, out_size, ws_size); grid = -1; return; }
        int dev = 0, cus = 0, per_cu = 0;
        if (hipGetDevice(&dev) != hipSuccess || hipDeviceGetAttribute(&cus, hipDeviceAttributeMultiprocessorCount, dev) != hipSuccess) { grid = -1; return; }
        if (hipFuncSetAttribute((const void*)mega, hipFuncAttributeMaxDynamicSharedMemorySize, LDS_BYTES) != hipSuccess) { fprintf(stderr, "kernel_launch: hipFuncSetAttribute failed\n"); grid = -1; return; }
        if (hipOccupancyMaxActiveBlocksPerMultiprocessor(&per_cu, (const void*)mega, NWAVES * 64, LDS_BYTES) != hipSuccess || per_cu < 1) { fprintf(stderr, "kernel_launch: occupancy query gave %d\n", per_cu); per_cu = 1; }
        (void)hipGetLastError();
        if (per_cu > 1) per_cu = 1;
        grid = cus * per_cu;
    }
    if (grid < 0) return;
    Args a{};
    for (int i = 0; i < 25; ++i) a.in[i] = (const float*)d_in[i];
    a.out = (float*)d_out; a.ws = (unsigned char*)d_ws;
    unsigned char* ws = (unsigned char*)d_ws;
#if CFG_SINGLE && (CFG_DUMB_MASK == 0)
    if (hipMemsetAsync((char*)d_ws + WS_CTL, 0, 65536, stream) != hipSuccess) { fprintf(stderr, "kernel_launch: memset failed\n"); return; }
    launch_mega(grid, a, 0, NPHASE, true, stream);
#else
    bf16 *S0 = (bf16*)(ws + WS_S0), *S1 = (bf16*)(ws + WS_S1), *S2 = (bf16*)(ws + WS_S2), *S3 = (bf16*)(ws + WS_S3), *S4 = (bf16*)(ws + WS_S4), *S5 = (bf16*)(ws + WS_S5);
    float* rc = (float*)(ws + WS_ROPE); float* rs = (float*)(ws + WS_ROPE + 256 * 1024);
    for (int p = 0; p < NPHASE; ++p) {
        if (!((CFG_DUMB_MASK >> p) & 1)) { launch_mega(grid, a, p, p + 1, false, stream); continue; }
        DumbEpi e{};
        switch (p) {
        case 1: e.kind = 1; e.o0 = S1; e.o1 = S2; e.f0 = (const float*)(ws + WS_RINV0);
            hipLaunchKernelGGL(dumb_gemm, dim3(2048 / 64, M / 64), dim3(256), 0, stream, (const bf16*)S0, (const bf16*)(ws + WS_WIN), 2048, D, e); break;
        case 2: hipLaunchKernelGGL(dumb_ssm, dim3(256), dim3(64), 0, stream, (const bf16*)S1, S0, a.in[I_LRE], a.in[I_LIM], a.in[I_LOGDT], a.in[I_BRE], a.in[I_BIM], a.in[I_CRE], a.in[I_CIM], a.in[I_AD]); break;
        case 3: e.kind = 3; e.o0 = S1; e.i0 = S0; e.i1 = S2; e.f0 = a.in[I_GLUB];
            hipLaunchKernelGGL(dumb_gemm, dim3(1024 / 64, M / 64), dim3(256), 0, stream, (const bf16*)S0, (const bf16*)(ws + WS_WGLU), 1024, D, e); break;
        case 4: e.kind = 4; e.o0 = S0; e.f0 = a.in[I_X]; e.fo = a.out;
            hipLaunchKernelGGL(dumb_gemm, dim3(1024 / 64, M / 64), dim3(256), 0, stream, (const bf16*)S1, (const bf16*)(ws + WS_WOUT), 1024, D, e);
            hipLaunchKernelGGL(dumb_rowss, dim3(M / 4), dim3(256), 0, stream, (const float*)a.out, (float*)(ws + WS_PSS1)); break;
        case 5: e.kind = 5; e.o0 = S1; e.o1 = S2; e.o2 = S3; e.o3 = S4; e.f0 = (const float*)(ws + WS_PSS1);
            hipLaunchKernelGGL(dumb_gemm, dim3(4096 / 64, M / 64), dim3(256), 0, stream, (const bf16*)S0, (const bf16*)(ws + WS_WKVQ), 4096, D, e);
            hipLaunchKernelGGL(dumb_rope, dim3(M * 128 / 256), dim3(256), 0, stream, S1, (const float*)rc, (const float*)rs);
            hipLaunchKernelGGL(dumb_rope, dim3(M * 128 / 256), dim3(256), 0, stream, S3, (const float*)rc, (const float*)rs); break;
        case 6: hipLaunchKernelGGL(dumb_attn, dim3(T, 16, BATCH), dim3(128), 0, stream, (const bf16*)S3, (const bf16*)S1, (const bf16*)S2, S0, S5); break;
        case 8: e.kind = 4; e.o0 = nullptr; e.f0 = a.out; e.fo = a.out;
            hipLaunchKernelGGL(dumb_gemm, dim3(1024 / 64, M / 64), dim3(256), 0, stream, (const bf16*)S1, (const bf16*)(ws + WS_WBO), 1024, D, e);
            hipLaunchKernelGGL(dumb_rowss, dim3(M / 4), dim3(256), 0, stream, (const float*)a.out, (float*)(ws + WS_PSS2)); break;
        default: launch_mega(grid, a, p, p + 1, false, stream); break;
        }
    }
#endif
}
```

```cpp
#include <hip/hip_runtime.h>
#include <hip/hip_cooperative_groups.h>
#include <hip/hip_bf16.h>
#include <cstdio>
#include <cstdint>
#include <cmath>
namespace pg8 {
#define PG8_LAS __attribute__((address_space(3)))
typedef unsigned short bf16_t;
typedef short bf16x8 __attribute__((ext_vector_type(8)));
typedef float f32x4 __attribute__((ext_vector_type(4)));
typedef unsigned u32x4 __attribute__((ext_vector_type(4)));
constexpr int BM = 256, BK = 64, HALF = 128, HTB = HALF * BK * 2  , STAGE_BYTES = 8 * HTB, NXCD = 8, WGM = 8;

__host__ __device__ __forceinline__ int lds_byte(int r, int c) { const int st = (r >> 4) * 2 + (c >> 5), rr = r & 15, cc = c & 31, ob = rr * 64 + cc * 2; return st * 1024 + (ob ^ (((ob >> 9) & 1) << 5)); }
__host__ __device__ __forceinline__ void stage_rc(int b, int& R, int& C) { const int st = b / 1024, sb = b % 1024, swz = sb ^ (((sb >> 9) & 1) << 5); R = (st >> 1) * 16 + swz / 64; C = (st & 1) * 32 + (swz % 64) / 2; }
__host__ __device__ __forceinline__ int perm32(int rho) { const int n = rho >> 4, i = rho & 15; return 8 * (i >> 2) + 4 * n + (i & 3); }

struct Unit { int pm, pn; };
struct Gemm { const bf16_t* A; const bf16_t* Bt; int M, N, K; };

struct StaticOrder {
    int nM, nN, nwg, G, c;
    __host__ __device__ void init(int M, int N, int G_, int c_) { nM = M / BM; nN = N / BM; nwg = nM * nN; G = G_; c = c_; }
    __host__ __device__ bool next(int i, Unit& u) const {
        const long L = (long)i * G + c; if (L >= nwg) return false;
        int wgid = (int)L; { const int q = nwg / NXCD, r = nwg % NXCD, xcd = wgid % NXCD, off = wgid / NXCD; wgid = (xcd < r ? xcd * (q + 1) : r * (q + 1) + (xcd - r) * q) + off; }
        const int nig = WGM * nN, gid = wgid / nig, fm = gid * WGM, gsz = (nM - fm) < WGM ? (nM - fm) : WGM;
        u.pm = fm + ((wgid % nig) % gsz); u.pn = (wgid % nig) / gsz; return true;
    }
    __device__ __forceinline__ void a_ready(const Unit&) const {}
    __device__ __forceinline__ void done(const Unit&) const {}
};

__device__ __forceinline__ unsigned cvt_pk_bf16(float lo, float hi) { unsigned r; asm volatile("v_cvt_pk_bf16_f32 %0, %1, %2" : "=v"(r) : "v"(lo), "v"(hi)); return r; }
__device__ __forceinline__ int lane_id() { return (int)__builtin_amdgcn_mbcnt_hi(~0u, __builtin_amdgcn_mbcnt_lo(~0u, 0u)); }
__device__ __forceinline__ int lane_id_v() { int r; asm volatile("v_mbcnt_lo_u32_b32 %0, -1, 0\n\tv_mbcnt_hi_u32_b32 %0, -1, %0" : "=v"(r)); return r; }
__device__ __forceinline__ float bf_lo(unsigned w) { return __uint_as_float(w << 16); }
__device__ __forceinline__ float bf_hi(unsigned w) { return __uint_as_float(w & 0xffff0000u); }
__device__ __forceinline__ float sigm_f(float z) { return __builtin_amdgcn_rcpf(1.f + __builtin_amdgcn_exp2f(-1.4426950408889634f * z)); }
__device__ __forceinline__ float silu_f(float z) { return z * sigm_f(z); }
__device__ __forceinline__ u32x4 pack8(const f32x4 a, const f32x4 b) { u32x4 w; w.x = cvt_pk_bf16(a[0], a[1]); w.y = cvt_pk_bf16(a[2], a[3]); w.z = cvt_pk_bf16(b[0], b[1]); w.w = cvt_pk_bf16(b[2], b[3]); return w; }

struct EpiUZ {
    static constexpr bool PERM = true, AFTER_DRAIN = false;
    bf16_t* U; bf16_t* ZG; const float* rinv;
    __device__ __forceinline__ void operator()(const f32x4 (&acc)[2][2][4][2], const Unit& u, int wr, int wc, int fr, int fq) const {
        const bool isz = u.pn >= 4; bf16_t* base = isz ? ZG : U; const int colt = (isz ? u.pn - 4 : u.pn) * BM + wc * 32 + 8 * fq;
        float rv[2][4];
#pragma unroll
        for (int ai = 0; ai < 2; ++ai)
#pragma unroll
            for (int m = 0; m < 4; ++m) rv[ai][m] = rinv[u.pm * BM + ai * HALF + wr * 64 + m * 16 + fr];
#pragma unroll
        for (int ai = 0; ai < 2; ++ai)
#pragma unroll
            for (int m = 0; m < 4; ++m) { const int row = u.pm * BM + ai * HALF + wr * 64 + m * 16 + fr; const float ri = rv[ai][m];
                bf16_t* rowp = isz ? base + (size_t)row * 1024 + colt : base + ((size_t)((row >> 13) * 64 + (colt >> 4)) * 8192 + (row & 8191)) * 16 + (colt & 8);
                const size_t bjstep = isz ? (size_t)HALF : (size_t)(HALF / 16) * 8192 * 16;
#pragma unroll
                for (int bj = 0; bj < 2; ++bj) { f32x4 v0 = acc[ai][bj][m][0] * ri, v1 = acc[ai][bj][m][1] * ri;
                    if (isz) {
#pragma unroll
                        for (int k = 0; k < 4; ++k) { v0[k] = silu_f(v0[k]); v1[k] = silu_f(v1[k]); } }
                    *(u32x4*)(rowp + bj * bjstep) = pack8(v0, v1); } }
    }
};
struct EpiGlu {
    static constexpr bool PERM = true, AFTER_DRAIN = false;
    const bf16_t* YG; const bf16_t* ZG; const float* bias; bf16_t* Y2;
    __device__ __forceinline__ void operator()(const f32x4 (&acc)[2][2][4][2], const Unit& u, int wr, int wc, int fr, int fq) const {
        const int col0 = u.pn * BM + wc * 32 + 8 * fq;
        f32x4 bv[2][2];
#pragma unroll
        for (int bj = 0; bj < 2; ++bj)
#pragma unroll
            for (int n = 0; n < 2; ++n) bv[bj][n] = *(const f32x4*)(bias + col0 + bj * HALF + 4 * n);
#pragma unroll
        for (int ai = 0; ai < 2; ++ai) {
            u32x4 yw[4][2], zw[4][2];
#pragma unroll
            for (int m = 0; m < 4; ++m)
#pragma unroll
                for (int bj = 0; bj < 2; ++bj) { const size_t off = (size_t)(u.pm * BM + ai * HALF + wr * 64 + m * 16 + fr) * 1024 + col0 + bj * HALF; yw[m][bj] = *(const u32x4*)(YG + off); zw[m][bj] = *(const u32x4*)(ZG + off); }
#pragma unroll
            for (int m = 0; m < 4; ++m)
#pragma unroll
                for (int bj = 0; bj < 2; ++bj) { const size_t off = (size_t)(u.pm * BM + ai * HALF + wr * 64 + m * 16 + fr) * 1024 + col0 + bj * HALF;
                    const u32x4 y = yw[m][bj], z = zw[m][bj];
                    const f32x4 t0 = acc[ai][bj][m][0] + bv[bj][0], t1 = acc[ai][bj][m][1] + bv[bj][1];
                    f32x4 o0, o1;
                    o0[0] = bf_lo(y.x) * sigm_f(t0[0]) * bf_lo(z.x); o0[1] = bf_hi(y.x) * sigm_f(t0[1]) * bf_hi(z.x);
                    o0[2] = bf_lo(y.y) * sigm_f(t0[2]) * bf_lo(z.y); o0[3] = bf_hi(y.y) * sigm_f(t0[3]) * bf_hi(z.y);
                    o1[0] = bf_lo(y.z) * sigm_f(t1[0]) * bf_lo(z.z); o1[1] = bf_hi(y.z) * sigm_f(t1[1]) * bf_hi(z.z);
                    o1[2] = bf_lo(y.w) * sigm_f(t1[2]) * bf_lo(z.w); o1[3] = bf_hi(y.w) * sigm_f(t1[3]) * bf_hi(z.w);
                    *(u32x4*)(Y2 + off) = pack8(o0, o1); }
        }
    }
};
template <bool BASE_BF16> struct EpiRes {
    static constexpr bool PERM = true, AFTER_DRAIN = false;
    const void* X; bf16_t* HB; float* PSS;
    __device__ __forceinline__ void operator()(const f32x4 (&acc)[2][2][4][2], const Unit& u, int wr, int wc, int fr, int fq) const {
        const int col0 = u.pn * BM + wc * 32 + 8 * fq;
#pragma unroll
        for (int ai = 0; ai < 2; ++ai) {
            f32x4 b0[4][2], b1[4][2];
#pragma unroll
            for (int m = 0; m < 4; ++m)
#pragma unroll
                for (int bj = 0; bj < 2; ++bj) { const size_t off = (size_t)(u.pm * BM + ai * HALF + wr * 64 + m * 16 + fr) * 1024 + col0 + bj * HALF;
                    if (BASE_BF16) { const u32x4 w = *(const u32x4*)((const bf16_t*)X + off); b0[m][bj] = (f32x4){bf_lo(w.x), bf_hi(w.x), bf_lo(w.y), bf_hi(w.y)}; b1[m][bj] = (f32x4){bf_lo(w.z), bf_hi(w.z), bf_lo(w.w), bf_hi(w.w)}; }
                    else { b0[m][bj] = *(const f32x4*)((const float*)X + off); b1[m][bj] = *(const f32x4*)((const float*)X + off + 4); } }
#pragma unroll
            for (int m = 0; m < 4; ++m) { const int row = u.pm * BM + ai * HALF + wr * 64 + m * 16 + fr; float ss = 0.f;
#pragma unroll
                for (int bj = 0; bj < 2; ++bj) { const size_t off = (size_t)row * 1024 + col0 + bj * HALF;
                    const f32x4 h0 = b0[m][bj] + acc[ai][bj][m][0], h1 = b1[m][bj] + acc[ai][bj][m][1];
                    *(u32x4*)(HB + off) = pack8(h0, h1);
                    ss += (h0[0] * h0[0] + h0[1] * h0[1]) + (h0[2] * h0[2] + h0[3] * h0[3]) + (h1[0] * h1[0] + h1[1] * h1[1]) + (h1[2] * h1[2] + h1[3] * h1[3]); }
                ss += __shfl_xor(ss, 16); ss += __shfl_xor(ss, 32);
                if (fq == 0) PSS[(size_t)row * 16 + u.pn * 4 + wc] = ss; }
        }
    }
};
struct EpiKVQZ {
    static constexpr bool PERM = true, AFTER_DRAIN = false;
    bf16_t *K, *V, *Q, *ZG2; const float* PSS1; const float* ropec; const float* ropes; float qscale;
    __device__ __forceinline__ void operator()(const f32x4 (&acc)[2][2][4][2], const Unit& u, int wr, int wc, int fr, int fq) const {
        const int seg = u.pn >> 2; bf16_t* base = seg == 0 ? K : seg == 1 ? V : seg == 2 ? Q : ZG2; const int colt = (u.pn & 3) * BM + wc * 32 + 8 * fq;
        const bool roped = (seg == 0 || seg == 2) && ((wc & 1) == 0);
        const float sgn = fq == 0 ? -1.f : 1.f;
#pragma unroll
        for (int ai = 0; ai < 2; ++ai)
#pragma unroll
            for (int m = 0; m < 4; ++m) { const int row = u.pm * BM + ai * HALF + wr * 64 + m * 16 + fr;
                const f32x4* ps = (const f32x4*)(PSS1 + (size_t)row * 16); const f32x4 pa = ps[0], pb = ps[1], pc = ps[2], pd = ps[3];
                const float ssum = ((pa[0] + pa[1]) + (pa[2] + pa[3])) + ((pb[0] + pb[1]) + (pb[2] + pb[3])) + ((pc[0] + pc[1]) + (pc[2] + pc[3])) + ((pd[0] + pd[1]) + (pd[2] + pd[3]));
                float ri = 1.0f / sqrtf(ssum * (1.0f / 1024.0f) + 1e-6f); if (seg == 2) ri *= qscale;
                f32x4 c0, c1, s0, s1;
                if (roped) { const int pos = row & 8191; c0 = *(const f32x4*)(ropec + pos * 8); c1 = *(const f32x4*)(ropec + pos * 8 + 4); s0 = *(const f32x4*)(ropes + pos * 8); s1 = *(const f32x4*)(ropes + pos * 8 + 4); }
#pragma unroll
                for (int bj = 0; bj < 2; ++bj) { f32x4 v0 = acc[ai][bj][m][0] * ri, v1 = acc[ai][bj][m][1] * ri;
                    if (roped) { f32x4 p0, p1;
#pragma unroll
                        for (int k = 0; k < 4; ++k) { p0[k] = __int_as_float(__builtin_amdgcn_ds_swizzle(__float_as_int(v0[k]), 0x401F)); p1[k] = __int_as_float(__builtin_amdgcn_ds_swizzle(__float_as_int(v1[k]), 0x401F)); }
                        if (fq < 2) {
#pragma unroll
                            for (int k = 0; k < 4; ++k) { v0[k] = v0[k] * c0[k] + sgn * p0[k] * s0[k]; v1[k] = v1[k] * c1[k] + sgn * p1[k] * s1[k]; } } }
                    if (seg == 3) {
#pragma unroll
                        for (int k = 0; k < 4; ++k) { v0[k] = silu_f(v0[k]); v1[k] = silu_f(v1[k]); } }
                    *(u32x4*)(base + (size_t)row * 1024 + colt + bj * HALF) = pack8(v0, v1); } }
    }
};
template <class Epi, class Sched, bool ALIGN_EPI = false, bool SP2 = false>
__device__ __forceinline__ void gemm_phase(const int wv, PG8_LAS unsigned char* lds, const Gemm g, const Sched& S, const Epi& E) {
    const int lane = lane_id(), wid = wv, tid = wv * 64 + lane, wr = wid >> 2, wc = wid & 3, fr = lane & 15, fq = lane >> 4;
    const int K = g.K, nt = K / BK;
    unsigned voffA[2], voffB[2];
#pragma unroll
    for (int i = 0; i < 2; ++i) { int R, C; stage_rc(tid * 16 + i * 8192, R, C); const int Rb = Epi::PERM ? ((R & ~31) + perm32(R & 31)) : R;
        voffA[i] = (unsigned)(R * K + C) * 2u; voffB[i] = (unsigned)(Rb * K + C) * 2u; }
    const size_t kstep = (size_t)(BK * 2);
    const size_t hstep = (size_t)HALF * K * 2;
    const size_t tstep = 2 * hstep;
    const unsigned ldsw = (unsigned)wid * 1024u;
    const int aoff = lds_byte(wr * 64 + fr, fq * 8), boff = lds_byte(wc * 32 + fr, fq * 8);
#define PG8_SA(b, h) (((b) * 2 + (h)) * HTB)
#define PG8_SB(b, h) ((4 + (b) * 2 + (h)) * HTB)
#define PG8_STAGE(bufoff, gbase, voff) do { _Pragma("unroll") for (int _i = 0; _i < 2; ++_i) \
        __builtin_amdgcn_global_load_lds((const unsigned*)((const char*)(gbase) + (voff)[_i]), (PG8_LAS unsigned*)(lds + (bufoff) + ldsw + _i * 8192), 16, 0, 0); } while (0)
#define PG8_LDA(dst, b, h) do { _Pragma("unroll") for (int m = 0; m < 4; ++m) _Pragma("unroll") for (int k = 0; k < 2; ++k) dst[m][k] = *(const PG8_LAS bf16x8*)(lds + PG8_SA(b, h) + aoff + m * 2048 + k * 1024); } while (0)
#define PG8_LDB(dst, b, h) do { _Pragma("unroll") for (int n = 0; n < 2; ++n) _Pragma("unroll") for (int k = 0; k < 2; ++k) dst[n][k] = *(const PG8_LAS bf16x8*)(lds + PG8_SB(b, h) + boff + n * 2048 + k * 1024); } while (0)
#define PG8_MMA(ai, bj, At, Bt) do { __builtin_amdgcn_s_setprio(1); _Pragma("unroll") for (int m = 0; m < 4; ++m) _Pragma("unroll") for (int n = 0; n < 2; ++n) _Pragma("unroll") for (int k = 0; k < 2; ++k) \
        acc[ai][bj][m][n] = __builtin_amdgcn_mfma_f32_16x16x32_bf16(Bt[n][k], At[m][k], acc[ai][bj][m][n], 0, 0, 0); __builtin_amdgcn_s_setprio(0); } while (0)
#define PG8_WAIT_V(n) asm volatile("s_waitcnt vmcnt(" #n ")" ::: "memory")
#define PG8_WAIT_L(n) asm volatile("s_waitcnt lgkmcnt(" #n ")" ::: "memory")
#define PG8_BAR __builtin_amdgcn_s_barrier()
#define PG8_SCHED __builtin_amdgcn_sched_barrier(0)
    Unit cur, nxt; int ui = 0;
    if (!S.next(0, cur)) return;
    f32x4 acc[2][2][4][2];
#pragma unroll
    for (int a = 0; a < 2; ++a)
#pragma unroll
        for (int b = 0; b < 2; ++b)
#pragma unroll
            for (int m = 0; m < 4; ++m)
#pragma unroll
                for (int n = 0; n < 2; ++n) acc[a][b][m][n] = (f32x4){0.f, 0.f, 0.f, 0.f};
    bf16x8 At[4][2], B0[2][2], B1[2][2];
    const char* cA = (const char*)g.A + (size_t)cur.pm * tstep; const char* cB = (const char*)g.Bt + (size_t)cur.pn * tstep;
    S.a_ready(cur);
    if constexpr (SP2) {
        PG8_STAGE(PG8_SB(0, 0), cB, voffB); PG8_STAGE(PG8_SB(0, 1), cB + hstep, voffB); PG8_STAGE(PG8_SA(0, 0), cA, voffA); PG8_STAGE(PG8_SA(0, 1), cA + hstep, voffA);
        if (wr == 1) PG8_BAR;
        PG8_WAIT_V(2); PG8_BAR;
        PG8_STAGE(PG8_SB(1, 0), cB + kstep, voffB); PG8_STAGE(PG8_SA(1, 0), cA + kstep, voffA); PG8_STAGE(PG8_SB(1, 1), cB + hstep + kstep, voffB);
        PG8_WAIT_V(6); PG8_BAR;
    } else {
        PG8_STAGE(PG8_SB(0, 0), cB, voffB); PG8_STAGE(PG8_SA(0, 0), cA, voffA); PG8_STAGE(PG8_SB(0, 1), cB + hstep, voffB); PG8_STAGE(PG8_SA(0, 1), cA + hstep, voffA);
        if (wr == 1) PG8_BAR;
        PG8_WAIT_V(4); PG8_BAR;
        PG8_STAGE(PG8_SB(1, 0), cB + kstep, voffB); PG8_STAGE(PG8_SA(1, 0), cA + kstep, voffA); PG8_STAGE(PG8_SB(1, 1), cB + hstep + kstep, voffB);
        PG8_WAIT_V(6); PG8_BAR;
    }
    for (;;) {
        const bool has_next = S.next(ui + 1, nxt);
        const char* nA = has_next ? (const char*)g.A + (size_t)nxt.pm * tstep : cA; const char* nB = has_next ? (const char*)g.Bt + (size_t)nxt.pn * tstep : cB;
        for (int t = 0; t < nt; t += 2) {
            const bool last = (t == nt - 2);
            const char* a1 = cA + (size_t)(t + 1) * kstep;
            const char* a2 = last ? nA : cA + (size_t)(t + 2) * kstep; const char* b2 = last ? nB : cB + (size_t)(t + 2) * kstep;
            const char* a3 = a2 + kstep; const char* b3 = b2 + kstep;
            if (last && has_next) S.a_ready(nxt);
            if constexpr (SP2) {
            PG8_LDB(B0, 0, 0); PG8_LDB(B1, 0, 1); PG8_SCHED; PG8_LDA(At, 0, 0); PG8_STAGE(PG8_SA(1, 1), a1 + hstep, voffA);
            PG8_WAIT_V(8); PG8_WAIT_L(0); PG8_BAR; PG8_MMA(0, 0, At, B0); PG8_MMA(0, 1, At, B1); PG8_BAR; PG8_SCHED;
            PG8_LDA(At, 0, 1); PG8_STAGE(PG8_SB(0, 0), b2, voffB); PG8_STAGE(PG8_SB(0, 1), b2 + hstep, voffB); PG8_STAGE(PG8_SA(0, 0), a2, voffA);
            PG8_WAIT_V(8); PG8_WAIT_L(0); PG8_BAR; PG8_MMA(1, 0, At, B0); PG8_MMA(1, 1, At, B1); PG8_BAR; PG8_SCHED;
            PG8_LDB(B0, 1, 0); PG8_LDB(B1, 1, 1); PG8_SCHED; PG8_LDA(At, 1, 0); PG8_STAGE(PG8_SA(0, 1), a2 + hstep, voffA);
            PG8_WAIT_V(8); PG8_WAIT_L(0); PG8_BAR; PG8_MMA(0, 0, At, B0); PG8_MMA(0, 1, At, B1); PG8_BAR; PG8_SCHED;
            PG8_LDA(At, 1, 1); PG8_STAGE(PG8_SB(1, 0), b3, voffB); PG8_STAGE(PG8_SB(1, 1), b3 + hstep, voffB); PG8_STAGE(PG8_SA(1, 0), a3, voffA);
            PG8_WAIT_V(8); PG8_WAIT_L(0); PG8_BAR; PG8_MMA(1, 0, At, B0); PG8_MMA(1, 1, At, B1); PG8_BAR; PG8_SCHED;
            } else {
            PG8_LDB(B0, 0, 0); PG8_SCHED; PG8_LDA(At, 0, 0); PG8_STAGE(PG8_SA(1, 1), a1 + hstep, voffA);
            PG8_WAIT_L(8); PG8_BAR; PG8_WAIT_L(0); PG8_MMA(0, 0, At, B0); PG8_BAR; PG8_SCHED;
            PG8_LDB(B1, 0, 1); PG8_STAGE(PG8_SB(0, 0), b2, voffB);
            PG8_BAR; PG8_WAIT_L(0); PG8_MMA(0, 1, At, B1); PG8_BAR;
            PG8_LDA(At, 0, 1); PG8_STAGE(PG8_SA(0, 0), a2, voffA);
            PG8_BAR; PG8_WAIT_L(0); PG8_MMA(1, 0, At, B0); PG8_BAR; PG8_SCHED;
            PG8_STAGE(PG8_SB(0, 1), b2 + hstep, voffB);
            PG8_WAIT_V(6); PG8_BAR; PG8_MMA(1, 1, At, B1); PG8_BAR;
            PG8_LDB(B0, 1, 0); PG8_SCHED; PG8_LDA(At, 1, 0); PG8_STAGE(PG8_SA(0, 1), a2 + hstep, voffA);
            PG8_WAIT_L(8); PG8_BAR; PG8_WAIT_L(0); PG8_MMA(0, 0, At, B0); PG8_BAR; PG8_SCHED;
            PG8_LDB(B1, 1, 1); PG8_STAGE(PG8_SB(1, 0), b3, voffB);
            PG8_BAR; PG8_WAIT_L(0); PG8_MMA(0, 1, At, B1); PG8_BAR;
            PG8_LDA(At, 1, 1); PG8_STAGE(PG8_SA(1, 0), a3, voffA);
            PG8_BAR; PG8_WAIT_L(0); PG8_MMA(1, 0, At, B0); PG8_BAR; PG8_SCHED;
            PG8_STAGE(PG8_SB(1, 1), b3 + hstep, voffB);
            PG8_WAIT_V(6); PG8_BAR; PG8_MMA(1, 1, At, B1); PG8_BAR;
            }
        }
        if constexpr (ALIGN_EPI) { if (wr == 0) PG8_BAR; }
        if constexpr (!Epi::AFTER_DRAIN) { E(acc, cur, wr, wc, fr, fq); S.done(cur); }
        if (!has_next) break;
#pragma unroll
        for (int a = 0; a < 2; ++a)
#pragma unroll
            for (int b = 0; b < 2; ++b)
#pragma unroll
                for (int m = 0; m < 4; ++m)
#pragma unroll
                    for (int n = 0; n < 2; ++n) acc[a][b][m][n] = (f32x4){0.f, 0.f, 0.f, 0.f};
        cur = nxt; cA = nA; cB = nB; ++ui;
        if constexpr (ALIGN_EPI) { if (wr == 1) PG8_BAR; }
    }
    PG8_WAIT_V(0);
    if constexpr (!ALIGN_EPI) { if (wr == 0) PG8_BAR; }
    PG8_BAR;
    if constexpr (Epi::AFTER_DRAIN) { E.fused(acc, cur, wr, wc, fr, fq, lds, wid, lane); S.done(cur); }
#undef PG8_SA
#undef PG8_SB
#undef PG8_STAGE
#undef PG8_LDA
#undef PG8_LDB
#undef PG8_MMA
#undef PG8_WAIT_V
#undef PG8_WAIT_L
#undef PG8_BAR
#undef PG8_SCHED
}
}
#define PG8_SP2 true
#define PG8_ALIGN true
namespace attn_body {
using bf16=__hip_bfloat16;
using bf16x8=__attribute__((ext_vector_type(8)))short;
using s16x4=__attribute__((ext_vector_type(4)))short;
using f32x16=__attribute__((ext_vector_type(16)))float;
using u32x4=__attribute__((ext_vector_type(4)))unsigned;
constexpr int BATCH=4,NHEAD=16,SEQ=8192,D=64,DM=NHEAD*D;
constexpr int NW=8,QBLK=32,QB=QBLK*NW,KVBLK=64,NQB=SEQ/QB;
constexpr int ATTN_PITCH=DM, ATTN_UNIT_ROWS=QB;
__device__ __forceinline__ int crow(int r,int hi){return (r&3)+8*(r>>2)+4*hi;}
#define SBAR() __builtin_amdgcn_sched_barrier(0)
__device__ __forceinline__ void cmask(f32x16&p0,f32x16&p1,int jb,int qrel,int hi){
  const float NEG=-INFINITY; int kb=64*jb+4*hi;
  #pragma unroll
  for(int r=0;r<16;++r){int kv=kb+(r&3)+8*(r>>2); if(kv>qrel)p0[r]=NEG; if(kv+32>qrel)p1[r]=NEG;}
}

constexpr int NSLOT=3, SLOTB=8192;
constexpr int LDS_K=0, LDS_V=NSLOT*SLOTB, LDS_WS=3*NSLOT*SLOTB, LDS_OST=LDS_WS+NW*64*4, LDS_BYTES=LDS_OST+NW*8192;
constexpr float C2=0.125f*1.4426950408889634f;
__device__ __forceinline__ void glds16(const void*gsrc,unsigned lds_dst){unsigned keep;
  asm volatile("s_mov_b32 %0, m0\n\ts_mov_b32 m0, %2\n\ts_nop 0\n\tglobal_load_lds_dwordx4 %1, off\n\ts_mov_b32 m0, %0":"=&s"(keep):"v"(gsrc),"s"(lds_dst):"memory");}
__device__ __forceinline__ int lane_opaque(){int r;asm volatile("v_mbcnt_lo_u32_b32 %0, -1, 0\n\tv_mbcnt_hi_u32_b32 %0, -1, %0":"=v"(r));return r;}
__device__ __forceinline__ float max3f(float a,float b,float c){float r;asm("v_max3_f32 %0, %1, %2, %3":"=v"(r):"v"(a),"v"(b),"v"(c));return r;}
__device__ __forceinline__ float max2f(float a,float b){float r;asm("v_max_f32_e32 %0, %1, %2":"=v"(r):"v"(a),"v"(b));return r;}
__device__ __forceinline__ float fadd_s(float a,float b){float r;asm("v_add_f32_e32 %0, %1, %2":"=v"(r):"v"(a),"v"(b));return r;}
__device__ __forceinline__ float fsub_s(float a,float b){float r;asm("v_sub_f32_e32 %0, %1, %2":"=v"(r):"v"(a),"v"(b));return r;}
typedef float f32x2_t __attribute__((ext_vector_type(2))); typedef __bf16 bf16x2_t __attribute__((ext_vector_type(2)));
__device__ __forceinline__ unsigned cvtpk_s(float lo,float hi){f32x2_t v={lo,hi};bf16x2_t b=__builtin_convertvector(v,bf16x2_t);return __builtin_bit_cast(unsigned,b);}
#define WAIT_BAR(N) asm volatile("s_waitcnt vmcnt(" #N ") lgkmcnt(0)\n\ts_barrier":::"memory")

__device__ __forceinline__ void qkt(f32x16&p0,f32x16&p1,const char*Kslot,const bf16x8*qr,int r32,int hi){
  const char*kb=Kslot+hi*1024+r32*16;
  #pragma unroll
  for(int d0=0;d0<4;++d0){
    const bf16x8 b0=*reinterpret_cast<const bf16x8*>(kb+d0*2048);
    const bf16x8 b1=*reinterpret_cast<const bf16x8*>(kb+d0*2048+512);
    if(d0==0){p0=__builtin_amdgcn_mfma_f32_32x32x16_bf16(b0,qr[0],f32x16{},0,0,0);p1=__builtin_amdgcn_mfma_f32_32x32x16_bf16(b1,qr[0],f32x16{},0,0,0);}
    else{p0=__builtin_amdgcn_mfma_f32_32x32x16_bf16(b0,qr[d0],p0,0,0,0);p1=__builtin_amdgcn_mfma_f32_32x32x16_bf16(b1,qr[d0],p1,0,0,0);}}
}
typedef __attribute__((address_space(3))) const char* lds_cptr;
typedef short v4i16_t __attribute__((ext_vector_type(4)));
__device__ __forceinline__ void kload8(bf16x8*kf,lds_cptr kp){
  kf[0]=*(const __attribute__((address_space(3))) bf16x8*)(kp);      kf[1]=*(const __attribute__((address_space(3))) bf16x8*)(kp+512);
  kf[2]=*(const __attribute__((address_space(3))) bf16x8*)(kp+2048); kf[3]=*(const __attribute__((address_space(3))) bf16x8*)(kp+2560);
  kf[4]=*(const __attribute__((address_space(3))) bf16x8*)(kp+4096); kf[5]=*(const __attribute__((address_space(3))) bf16x8*)(kp+4608);
  kf[6]=*(const __attribute__((address_space(3))) bf16x8*)(kp+6144); kf[7]=*(const __attribute__((address_space(3))) bf16x8*)(kp+6656);
}
__device__ __forceinline__ void kload2(bf16x8*kf,lds_cptr kp,int j){ kf[2*j]=*(const __attribute__((address_space(3))) bf16x8*)(kp+j*2048); kf[2*j+1]=*(const __attribute__((address_space(3))) bf16x8*)(kp+j*2048+512); }
__device__ __forceinline__ s16x4 vtr(lds_cptr p){ return __builtin_bit_cast(s16x4,__builtin_amdgcn_ds_read_tr16_b64_v4i16((__attribute__((address_space(3))) v4i16_t*)p)); }
__device__ __forceinline__ float rowmax(const f32x16&p0,const f32x16&p1){
  float a=max3f(p0[0],p0[1],p1[0]),b=max3f(p0[2],p0[3],p1[1]);a=max3f(a,p1[2],p1[3]);
  #pragma unroll
  for(int r=4;r<16;r+=4){a=max3f(a,p0[r],p0[r+1]);b=max3f(b,p0[r+2],p0[r+3]);a=max3f(a,p1[r],p1[r+1]);b=max3f(b,p1[r+2],p1[r+3]);}
  const float m=max2f(a,b);
  auto rr=__builtin_amdgcn_permlane32_swap(__float_as_uint(m),__float_as_uint(m),false,false);
  return max2f(__uint_as_float(rr[0]),__uint_as_float(rr[1]));
}
__device__ __forceinline__ void pv(f32x16*o,int vb,bf16x8 pa0,bf16x8 pa1,bf16x8 pa2,bf16x8 pa3){
  #pragma unroll
  for(int d0=0;d0<4;++d0){s16x4 lo[4],hi[4];
    #pragma unroll
    for(int ks=0;ks<4;++ks){
      asm volatile("ds_read_b64_tr_b16 %0,%1 offset:%c2":"=&v"(lo[ks]):"v"(vb),"i"((d0>>1)*8192+(d0&1)*4096+ks*1024):"memory");
      asm volatile("ds_read_b64_tr_b16 %0,%1 offset:%c2":"=&v"(hi[ks]):"v"(vb),"i"((d0>>1)*8192+(d0&1)*4096+ks*1024+512):"memory");}
    asm volatile("s_waitcnt lgkmcnt(0)":::"memory");SBAR();
    #define PK(k) (bf16x8){lo[k][0],lo[k][1],lo[k][2],lo[k][3],hi[k][0],hi[k][1],hi[k][2],hi[k][3]}
    o[d0]=__builtin_amdgcn_mfma_f32_32x32x16_bf16(pa0,PK(0),o[d0],0,0,0);
    o[d0]=__builtin_amdgcn_mfma_f32_32x32x16_bf16(pa1,PK(1),o[d0],0,0,0);
    o[d0]=__builtin_amdgcn_mfma_f32_32x32x16_bf16(pa2,PK(2),o[d0],0,0,0);
    o[d0]=__builtin_amdgcn_mfma_f32_32x32x16_bf16(pa3,PK(3),o[d0],0,0,0);
    #undef PK
  }
}

#ifndef ATTN_STORE16
#define ATTN_STORE16(p,v) (*(u32x4*)(p)=(v))
#endif
struct Comb { const bf16* ZG; bf16* A2; const float* subg; float lam, oml; };
template<int THRL> __device__ __forceinline__ void attn_unit(const int MODE,const int wv,int b,int h,int vcol,int qb,const bf16*Q,const bf16*__restrict__ K,const bf16*__restrict__ V,bf16*O,char*shm,const Comb&ca){
  const int lane=pg8::lane_id(),r32=lane&31,hi=lane>>5; const int wid=wv;
  const long rowbase=(long)b*SEQ; const int q0=qb*QB;
  const bf16*Qw=Q+(rowbase+q0+wid*QBLK)*DM+h*D;
  const bf16*Kh=K+rowbase*DM+h*D,*Vh=V+rowbase*DM+vcol;
  const unsigned lds0=(unsigned)(uintptr_t)shm;
  float*wsf=(float*)(shm+LDS_WS)+wid*64;
  const bf16*ksrc=Kh+(long)lane*DM+wid*8;
  const bf16*vsrc=Vh+(long)(16*(wid&3)+(lane>>2))*DM+(wid>>2)*32+(lane&3)*8;
  const unsigned kdst=lds0+LDS_K+wid*1024, vdst=lds0+LDS_V+wid*1024;
  #define DMA_K(t,slot) glds16(ksrc+(long)(t)*KVBLK*DM,(unsigned)__builtin_amdgcn_readfirstlane(kdst+(slot)))
  #define DMA_V(t,slot) do{ glds16(vsrc+(long)(t)*KVBLK*DM,(unsigned)__builtin_amdgcn_readfirstlane(vdst+2*(slot))); glds16(vsrc+64+(long)(t)*KVBLK*DM,(unsigned)__builtin_amdgcn_readfirstlane(vdst+2*(slot)+8192)); }while(0)
  const char*Kbase=shm+LDS_K; bf16x8 kf[8];
  const lds_cptr shm3=(lds_cptr)shm; const lds_cptr kp0=shm3+LDS_K+hi*1024+r32*16; const lds_cptr vp0=shm3+LDS_V+((lane>>4)&1)*32+(lane&3)*8+(4*hi+((lane&15)>>2))*64;
  const int NT=(q0+QB)/KVBLK;
  DMA_K(0,0);DMA_V(0,0);DMA_K(1,SLOTB);
  bf16x8 qr[4];
  #pragma unroll
  for(int d0=0;d0<4;++d0)qr[d0]=*reinterpret_cast<const bf16x8*>(&Qw[(long)r32*DM+d0*16+hi*8]);
  const lds_cptr qp_=shm3+LDS_OST+wid*8192+lane*16;
  #define QLD(d) (*(const __attribute__((address_space(3))) bf16x8*)(qp_+(d)*1024))
  float mhat=0.f,l_reg=0.f;f32x16 o[4];o[0]=f32x16{};o[1]=f32x16{};o[2]=f32x16{};o[3]=f32x16{};
  const int qrel=wid*QBLK+r32;
  #define CMASK(P0,P1,t) do{int jb_=(t)-(NT-4); if(jb_>=0)cmask(P0,P1,jb_,qrel,hi);}while(0)
  bool resc=false;
  #define START(P0,P1) do{ const float rm=rowmax(P0,P1); resc=false; \
    { const float dl=rm; mhat=fadd_s(mhat,dl); \
      _Pragma("unroll") for(int r=0;r<16;++r){P0[r]=fsub_s(P0[r],dl);P1[r]=fsub_s(P1[r],dl);} \
      } \
    _Pragma("unroll") for(int r=0;r<16;++r)P0[r]=__builtin_amdgcn_exp2f(P0[r]); }while(0)
  #define RESC() do{ if(resc){ asm volatile("s_waitcnt lgkmcnt(0)":::"memory"); \
      _Pragma("unroll") for(int d_=0;d_<4;++d_) _Pragma("unroll") for(int r=0;r<16;++r)o[d_][r]*=wsf[crow(r,hi)]; } }while(0)
  f32x16 pA0,pA1,pB0,pB1;
  int sl_prev=0,sl_cur=0,sl_next=SLOTB;
  #define ROT() do{sl_prev=sl_cur;sl_cur=sl_next;sl_next=(sl_next==(NSLOT-1)*SLOTB)?0:sl_next+SLOTB;}while(0)
  DMA_K(2,2*SLOTB);
  _Pragma("unroll") for(int d0=0;d0<4;++d0)*(__attribute__((address_space(3))) bf16x8*)(qp_+d0*1024)=qr[d0];
  WAIT_BAR(3);
  qkt(pA0,pA1,Kbase,qr,r32,hi);asm volatile("s_nop 15\n\ts_nop 7":"+v"(pA0),"+v"(pA1));CMASK(pA0,pA1,0);
  START(pA0,pA1);
  _Pragma("unroll") for(int r=0;r<16;++r)pA1[r]=__builtin_amdgcn_exp2f(pA1[r]);
  WAIT_BAR(0);
  DMA_K(3,0);DMA_V(1,SLOTB);
  ROT();
  kload8(kf,kp0+sl_cur);
  WAIT_BAR(3);
  s16x4 vlo[4],vhi[4]; u32x4 pw0,pw1,pw2,pw3;
  #define PKW(P,B) cvtpk_s(P[B],P[B+1])
  #define PAF(k) __builtin_bit_cast(bf16x8,pw##k)
  #define PIN(x) asm volatile("":"+v"(x))
  #define MX3(a,b,c) __builtin_fmaxf(__builtin_fmaxf((a),(b)),(c))
  #define GAPA(MF,A0,A1,A2,A3,W0,W1,PW) do{ MF; sacc+=A0; sacc+=A1; sacc+=A2; sacc+=A3; PIN(sacc); W0; W1; PIN(PW); SBAR(); }while(0)
  #define EX(v) __builtin_amdgcn_exp2f(v)
  #define GAPB(MF,X,B) do{ MF; X[B]=EX(X[B]-mhat); X[B+1]=EX(X[B+1]-mhat); PIN(X); SBAR(); }while(0)
  #define VRN(f) do{ vlo[(f)&3]=vtr(vp_+((((f)&3)>>1)*8192+((f)&1)*4096+((f)>>2)*1024)); vhi[(f)&3]=vtr(vp_+((((f)&3)>>1)*8192+((f)&1)*4096+((f)>>2)*1024+512)); }while(0)
  #define VFQ(i) (bf16x8){vlo[i][0],vlo[i][1],vlo[i][2],vlo[i][3],vhi[i][0],vhi[i][1],vhi[i][2],vhi[i][3]}
  #define MFB(k,d) o[d]=__builtin_amdgcn_mfma_f32_32x32x16_bf16(PAF(k),VFQ(d),o[d],0,0,0)
  #define KRD(G,j) do{ if(G){ kload2(kf,kp0+sl_next,j); SBAR(); } }while(0)
  #define STEP(C0,C1,P0,P1,t,GK,GV,GL) do{ SBAR(); \
    const lds_cptr vp_=vp0+2*sl_prev; \
    bf16x8 qa_=QLD(0), qb_=QLD(1); float sacc=(P0[0]+P0[1]); \
    GAPA(C0=__builtin_amdgcn_mfma_f32_32x32x16_bf16(kf[0],qa_,f32x16{},0,0,0), P0[2],P0[3],P0[4],P0[5],     pw0[0]=PKW(P0,0), pw0[1]=PKW(P0,2), pw0); \
    GAPA(C1=__builtin_amdgcn_mfma_f32_32x32x16_bf16(kf[1],qa_,f32x16{},0,0,0), P0[6],P0[7],P0[8],P0[9],     pw0[2]=PKW(P0,4), pw0[3]=PKW(P0,6), pw0); \
    qa_=QLD(2); \
    GAPA(C0=__builtin_amdgcn_mfma_f32_32x32x16_bf16(kf[2],qb_,C0,0,0,0),   P0[10],P0[11],P0[12],P0[13], pw1[0]=PKW(P0,8), pw1[1]=PKW(P0,10), pw1); \
    GAPA(C1=__builtin_amdgcn_mfma_f32_32x32x16_bf16(kf[3],qb_,C1,0,0,0),   P0[14],P0[15],P1[0],P1[1],   pw1[2]=PKW(P0,12),pw1[3]=PKW(P0,14), pw1); \
    qb_=QLD(3); \
    GAPA(C0=__builtin_amdgcn_mfma_f32_32x32x16_bf16(kf[4],qa_,C0,0,0,0),   P1[2],P1[3],P1[4],P1[5],     pw2[0]=PKW(P1,0), pw2[1]=PKW(P1,2), pw2); \
    GAPA(C1=__builtin_amdgcn_mfma_f32_32x32x16_bf16(kf[5],qa_,C1,0,0,0),   P1[6],P1[7],P1[8],P1[9],     pw2[2]=PKW(P1,4), pw2[3]=PKW(P1,6), pw2); \
    GAPA(C0=__builtin_amdgcn_mfma_f32_32x32x16_bf16(kf[6],qb_,C0,0,0,0),   P1[10],P1[11],P1[12],P1[13], pw3[0]=PKW(P1,8), pw3[1]=PKW(P1,10), pw3); \
    GAPA(C1=__builtin_amdgcn_mfma_f32_32x32x16_bf16(kf[7],qb_,C1,0,0,0),   P1[14],P1[15],0.f,0.f,       pw3[2]=PKW(P1,12),pw3[3]=PKW(P1,14), pw3); \
    l_reg+=sacc; \
    if(GK){DMA_K((t)+3,sl_cur);} if(GV){DMA_V((t)+1,sl_next);} \
    VRN(0); VRN(1); VRN(2); \
    CMASK(C0,C1,t); \
    { float a=MX3(C0[0],C0[1],C1[0]),b=MX3(C0[2],C0[3],C1[1]); a=MX3(a,C1[2],C1[3]); \
      _Pragma("unroll") for(int r=4;r<16;r+=4){a=MX3(a,C0[r],C0[r+1]);b=MX3(b,C0[r+2],C0[r+3]);a=MX3(a,C1[r],C1[r+1]);b=MX3(b,C1[r+2],C1[r+3]);} \
      float rm=__builtin_fmaxf(a,b); { auto rr=__builtin_amdgcn_permlane32_swap(__float_as_uint(rm),__float_as_uint(rm),false,false); rm=__builtin_fmaxf(__uint_as_float(rr[0]),__uint_as_float(rr[1]))-mhat; } \
      resc=false; \
      if(__builtin_expect(__any(rm>(float)THRL),0)){ const float dl=__builtin_fmaxf(rm,0.f); mhat+=dl; \
        const float f=__builtin_amdgcn_exp2f(-dl); l_reg*=f; if(hi==0)wsf[lane_opaque()&31]=f; resc=true; } } \
    SBAR(); \
    VRN(3);  GAPB(MFB(0,0), C0,0); \
    VRN(4);  GAPB(MFB(0,1), C0,2); \
    VRN(5);  GAPB(MFB(0,2), C0,4); \
    VRN(6);  GAPB(MFB(0,3), C0,6); \
    KRD(GL,0); VRN(7);  GAPB(MFB(1,0), C0,8); \
    VRN(8);  GAPB(MFB(1,1), C0,10); \
    KRD(GL,1); VRN(9);  GAPB(MFB(1,2), C0,12); \
    VRN(10); GAPB(MFB(1,3), C0,14); \
    KRD(GL,2); VRN(11); GAPB(MFB(2,0), C1,0); \
    VRN(12); GAPB(MFB(2,1), C1,2); \
    KRD(GL,3); VRN(13); GAPB(MFB(2,2), C1,4); \
    VRN(14); GAPB(MFB(2,3), C1,6); \
    VRN(15); GAPB(MFB(3,0), C1,8); \
    GAPB(MFB(3,1), C1,10); \
    GAPB(MFB(3,2), C1,12); \
    GAPB(MFB(3,3), C1,14); \
    }while(0)
  int t=1;
  #undef CMASK
  #define CMASK(P0,P1,t) do{}while(0)
  for(;t+5<NT;t+=2){
    STEP(pB0,pB1,pA0,pA1,t,true,true,true);     WAIT_BAR(3); RESC(); ROT();
    STEP(pA0,pA1,pB0,pB1,t+1,true,true,true);   WAIT_BAR(3); RESC(); ROT();
  }
  #undef CMASK
  #define CMASK(P0,P1,t) do{int jb_=(t)-(NT-4); if(jb_>=0)cmask(P0,P1,jb_,qrel,hi);}while(0)
  #define ENDW(tt) do{ if((tt)+3<NT){WAIT_BAR(3);} else if((tt)+2<NT){WAIT_BAR(2);} else {WAIT_BAR(0);} }while(0)
  for(;t+1<NT;t+=2){
    STEP(pB0,pB1,pA0,pA1,t,(t+3<NT),(t+1<NT),(t+1<NT));       ENDW(t);   RESC(); ROT();
    STEP(pA0,pA1,pB0,pB1,t+1,(t+4<NT),(t+2<NT),(t+2<NT));     ENDW(t+1); RESC(); ROT();
  }
  STEP(pB0,pB1,pA0,pA1,NT-1,false,false,false); RESC();
  { float sacc=pB0[0]+pB0[1]; _Pragma("unroll") for(int r=2;r<16;++r)sacc+=pB0[r]; _Pragma("unroll") for(int r=0;r<16;++r)sacc+=pB1[r]; l_reg+=sacc;
    pw0=(u32x4){PKW(pB0,0),PKW(pB0,2),PKW(pB0,4),PKW(pB0,6)};pw1=(u32x4){PKW(pB0,8),PKW(pB0,10),PKW(pB0,12),PKW(pB0,14)};pw2=(u32x4){PKW(pB1,0),PKW(pB1,2),PKW(pB1,4),PKW(pB1,6)};pw3=(u32x4){PKW(pB1,8),PKW(pB1,10),PKW(pB1,12),PKW(pB1,14)};
    SBAR(); const int vb0=(int)(lds0+LDS_V)+((lane>>4)&1)*32+(lane&3)*8+(4*hi+((lane&15)>>2))*64; pv(o,vb0+2*sl_cur,PAF(0),PAF(1),PAF(2),PAF(3)); }
  #undef PKW
  #undef PAF
  #undef VFQ
  #undef MFB
  #undef PIN
  #undef MX3
  #undef GAPA
  #undef GAPB
  #undef EX
  #undef VRN
  #undef KRD
  #undef STEP
  #undef ENDW
  {auto rr=__builtin_amdgcn_permlane32_swap(__float_as_uint(l_reg),__float_as_uint(l_reg),false,false);l_reg=__uint_as_float(rr[0])+__uint_as_float(rr[1]);}
  if(hi==0)wsf[32+r32]=l_reg;asm volatile("s_waitcnt lgkmcnt(0)":::"memory");
  float rli[16];
  #pragma unroll
  for(int r=0;r<16;++r)rli[r]=__builtin_amdgcn_rcpf(wsf[32+crow(r,hi)]);
  bf16*Ow=O+(rowbase+q0+wid*QBLK)*DM+vcol;
  { bf16*stg=(bf16*)(shm+LDS_OST)+wid*4096;
    #pragma unroll
    for(int r=0;r<16;++r){const int orow=crow(r,hi);
      #pragma unroll
      for(int d0=0;d0<4;++d0)stg[orow*128+d0*32+r32]=__float2bfloat16(o[d0][r]*rli[r]);}
    asm volatile("s_waitcnt lgkmcnt(0)":::"memory");
    const int ch=lane&15;
    if(MODE==0){
      #pragma unroll
      for(int i=0;i<8;++i){const int row=i*4+(lane>>4); const u32x4 v=*(const u32x4*)(stg+row*128+ch*8); ATTN_STORE16(Ow+(long)row*DM+ch*8,v);} }
    else{ const long off0=(long)(Ow-O)+(long)(lane>>4)*DM+ch*8;
      u32x4 v1[8],zw[8];
      #pragma unroll
      for(int i=0;i<8;++i){ v1[i]=*(const u32x4*)(O+off0+(long)i*4*DM); zw[i]=*(const u32x4*)(ca.ZG+off0+(long)i*4*DM); }
      const pg8::f32x4 g0=*(const pg8::f32x4*)(ca.subg+ch*8), g1=*(const pg8::f32x4*)(ca.subg+ch*8+4);
      #define BLO(w) __uint_as_float((w)<<16)
      #define BHI(w) __uint_as_float((w)&0xffff0000u)
      #pragma unroll
      for(int i=0;i<8;++i){ const int row=i*4+(lane>>4); const u32x4 v=*(const u32x4*)(stg+row*128+ch*8);
        float oo[8];
        oo[0]=BLO(v1[i].x)-ca.lam*BLO(v.x); oo[1]=BHI(v1[i].x)-ca.lam*BHI(v.x); oo[2]=BLO(v1[i].y)-ca.lam*BLO(v.y); oo[3]=BHI(v1[i].y)-ca.lam*BHI(v.y);
        oo[4]=BLO(v1[i].z)-ca.lam*BLO(v.z); oo[5]=BHI(v1[i].z)-ca.lam*BHI(v.z); oo[6]=BLO(v1[i].w)-ca.lam*BLO(v.w); oo[7]=BHI(v1[i].w)-ca.lam*BHI(v.w);
        float ss=(oo[0]*oo[0]+oo[1]*oo[1])+(oo[2]*oo[2]+oo[3]*oo[3])+(oo[4]*oo[4]+oo[5]*oo[5])+(oo[6]*oo[6]+oo[7]*oo[7]);
        ss+=__shfl_xor(ss,1); ss+=__shfl_xor(ss,2); ss+=__shfl_xor(ss,4); ss+=__shfl_xor(ss,8);
        const float ri=ca.oml/sqrtf(ss*(1.0f/128.0f)+1e-5f);
        u32x4 w; w.x=cvtpk_s(oo[0]*ri*g0[0]*BLO(zw[i].x),oo[1]*ri*g0[1]*BHI(zw[i].x)); w.y=cvtpk_s(oo[2]*ri*g0[2]*BLO(zw[i].y),oo[3]*ri*g0[3]*BHI(zw[i].y));
        w.z=cvtpk_s(oo[4]*ri*g1[0]*BLO(zw[i].z),oo[5]*ri*g1[1]*BHI(zw[i].z)); w.w=cvtpk_s(oo[6]*ri*g1[2]*BLO(zw[i].w),oo[7]*ri*g1[3]*BHI(zw[i].w));
        ATTN_STORE16(ca.A2+off0+(long)i*4*DM,w); }
      #undef BLO
      #undef BHI
    } }
  asm volatile("s_waitcnt lgkmcnt(0)\n\ts_barrier":::"memory");
  #undef QLD
  #undef DMA_K
  #undef DMA_V
  #undef CMASK
  #undef START
  #undef RESC
  #undef ROT
}
constexpr int ATTN_LDS_BYTES=LDS_BYTES;
struct AttnTensors { const bf16* Q; const bf16* K; const bf16* V; bf16* O1; };
struct AttnUnit { int b, h, qb; };
struct StaticOrder {
  int vcu, G;
  __device__ __forceinline__ explicit StaticOrder(int grid,int block):vcu((grid%8==0)?(block%8)*(grid/8)+block/8:block),G(grid){}
  __device__ __forceinline__ bool next(int i,AttnUnit&u)const{ const int r=i>>2,k=i&3; const int qd=vcu+G*r; if(qd>=256)return false; const int s=qd&7,bh=qd>>3;
    u.h=bh&7; u.b=bh>>3; u.qb=(k==0)?s:(k==1)?15-s:(k==2)?16+s:31-s; return true; }
  __device__ __forceinline__ void a_ready(const AttnUnit&)const{}
  __device__ __forceinline__ void done(const AttnUnit&)const{}
};
template<class Sched,int THRL=8> __device__ __forceinline__ void attn_phase(const int wv,char*lds,const AttnTensors&T,const Comb&ca,const Sched&S){
  AttnUnit u;
  for(int i2=0;S.next(i2>>1,u);++i2){ const int w=i2&1;
    attn_unit<THRL>(w,wv,u.b,2*u.h+w,u.h*128,u.qb,T.Q,T.K,T.V,T.O1,lds,ca); }
}
#undef SBAR
#undef WAIT_BAR
}
namespace cg = cooperative_groups;
#ifndef CFG_DUMB_MASK
#define CFG_DUMB_MASK 0
#endif
#ifndef CFG_SINGLE
#define CFG_SINGLE 1
#endif
constexpr int NWAVES = 8;
constexpr int BATCH = 4, T = 8192, D = 1024, M = BATCH * T;
constexpr int SSM_L = 32, NCH = T / SSM_L, KU = 16 * SSM_L;
constexpr float NORM_EPS = 1e-6f, SUBLN_EPS = 1e-5f;
constexpr float LAM_INIT = 0.35550906759096924f;
constexpr float QSCALE = 0.125f * 1.4426950408889634f;
constexpr int NPHASE = 10;

constexpr size_t MiB = 1u << 20;
constexpr size_t WS_CTL = 0;
constexpr size_t WS_WIN = 2 * MiB, WS_WGLU = 6 * MiB, WS_WOUT = 8 * MiB, WS_WKVQ = 10 * MiB, WS_WBO = 18 * MiB;
constexpr size_t WS_TAB = 20 * MiB, TAB_STRIDE = 286720;
constexpr size_t TAB_BPT = 0, TAB_CPT = 131072, TAB_KT = 262144, TAB_AL = 279040;
constexpr size_t WS_ROPE = 38 * MiB;
constexpr size_t WS_RINV0 = 39 * MiB, WS_LAM = 39 * MiB + 256 * 1024;
constexpr size_t WS_PSS1 = 40 * MiB, WS_PSS2 = 42 * MiB;
constexpr size_t WS_E = 48 * MiB, WS_XP = 80 * MiB;
constexpr size_t WS_S0 = 128 * MiB, WS_S1 = 192 * MiB, WS_S2 = 256 * MiB, WS_S3 = 320 * MiB, WS_S4 = 384 * MiB, WS_S5 = 448 * MiB, WS_END = 512 * MiB;
static_assert(WS_TAB + 64 * TAB_STRIDE <= WS_ROPE && WS_E + (size_t)256 * NCH * 128 * 4 <= WS_XP && WS_XP + (size_t)256 * NCH * 128 * 2 <= WS_S0, "ws map");
constexpr int LDS_BYTES = 147456, MISC_OFF = LDS_BYTES - 64;
static_assert(attn_body::ATTN_LDS_BYTES <= LDS_BYTES && pg8::STAGE_BYTES <= LDS_BYTES, "LDS map");

#define LAS __attribute__((address_space(3)))
typedef unsigned short bf16;
typedef unsigned v4u __attribute__((ext_vector_type(4)));
typedef float f32x4 __attribute__((ext_vector_type(4)));
typedef float f32x16 __attribute__((ext_vector_type(16)));
typedef short bf16x8 __attribute__((ext_vector_type(8)));
__device__ __forceinline__ unsigned f2bf(float f) { unsigned u = __builtin_bit_cast(unsigned, f); return (u + 0x7fffu + ((u >> 16) & 1u)) >> 16; }
__device__ __forceinline__ unsigned pk2(float lo, float hi) { return f2bf(lo) | (f2bf(hi) << 16); }
__device__ __forceinline__ float bf2f(bf16 v) { return __uint_as_float((unsigned)v << 16); }
__device__ __forceinline__ float wave_sum(float v) {
#pragma unroll
    for (int o = 1; o < 64; o <<= 1) v += __shfl_xor(v, o);
    return v;
}
__device__ __forceinline__ float gelu_erf(float v) { return 0.5f * v * (1.0f + erff(v * 0.70710678118654752f)); }
typedef float f32x2 __attribute__((ext_vector_type(2)));
__device__ __forceinline__ f32x2 gelu_pk(f32x2 v) {
    const f32x2 av = __builtin_elementwise_abs(v), d = av * 0.2316418882f + 1.0f;
    f32x2 t; t.x = __builtin_amdgcn_rcpf(d.x); t.y = __builtin_amdgcn_rcpf(d.y);
    f32x2 q = t * 0.5307027145f + (-0.7265760135f); q = q * t + 0.7107068705f; q = q * t + (-0.142248368f); q = q * t + 0.127414796f; q = q * t;
    const f32x2 s = (v * v) * (-0.72134752044f);
    f32x2 e; e.x = __builtin_amdgcn_exp2f(s.x); e.y = __builtin_amdgcn_exp2f(s.y);
    const f32x2 m = v * (q * e), r = v - m;
    f32x2 o; o.x = v.x < 0.f ? m.x : r.x; o.y = v.y < 0.f ? m.y : r.y; return o;
}
__device__ __forceinline__ int crow(int r, int hi) { return (r & 3) + 8 * (r >> 2) + 4 * hi; }

#define RLX_AGENT __ATOMIC_RELAXED, __HIP_MEMORY_SCOPE_AGENT
#define XB_TMO      128
#define XB_XCNT(j)  (256  + 64 * (j))
#define XB_XSUB(j)  (1280 + 64 * (j))
#define XB_XGEN(j)  (2304 + 64 * (j))
#define XB_TOP      3328
#define XB_TOPGEN   3392
#define XCD_BAR_WORDS 3456
#define XB_SPIN_CAP (1u << 22)

__device__ __forceinline__ unsigned xb_ld(unsigned* p)              { return __hip_atomic_load(p, __ATOMIC_RELAXED, __HIP_MEMORY_SCOPE_AGENT); }
__device__ __forceinline__ unsigned xb_add(unsigned* p, unsigned v) { return __hip_atomic_fetch_add(p, v, __ATOMIC_RELAXED, __HIP_MEMORY_SCOPE_AGENT); }
__device__ __forceinline__ unsigned xb_xcc_id() { return (unsigned)__builtin_amdgcn_s_getreg((3 << 11) | 20) & 0xFu; }
#define XB_SPIN(cond, bar) do { unsigned _sp = 0; while (cond) { __builtin_amdgcn_s_sleep(1); \
    if ((++_sp & 255u) == 0u) { if (xb_ld(&(bar)[XB_TMO])) break; if (_sp > XB_SPIN_CAP) { atomicAdd(&(bar)[XB_TMO], 1u); break; } } } } while (0)

struct XcdBarrier {
    unsigned* bar; unsigned x;
    volatile LAS unsigned* st;
};

__device__ __forceinline__ XcdBarrier xcd_barrier_post(unsigned* bar, volatile LAS unsigned* st, const bool t0) {
    XcdBarrier b; b.bar = bar; b.x = xb_xcc_id(); b.st = st;
    if (t0) (void)xb_add(&bar[XB_XCNT(b.x)], 1u);
    return b;
}
__device__ __forceinline__ void xcd_barrier_complete(unsigned* bar, unsigned x, unsigned& nloc, unsigned& nx) {
    const unsigned G = gridDim.x * gridDim.y * gridDim.z;
    unsigned sum, cnt, mine, sp = 0u;
    for (;;) {
        sum = 0u; cnt = 0u; mine = 0u;
#pragma unroll
        for (unsigned j = 0; j < 16; ++j) { const unsigned c = xb_ld(&bar[XB_XCNT(j)]); sum += c; cnt += (c > 0u) ? 1u : 0u; mine = (j == x) ? c : mine; }
        if (sum == G) break;
        __builtin_amdgcn_s_sleep(1);
        if ((++sp & 255u) == 0u) { if (xb_ld(&bar[XB_TMO])) break; if (sp > XB_SPIN_CAP) { atomicAdd(&bar[XB_TMO], 1u); break; } }
    }
    nloc = mine > 0u ? mine : 1u; nx = cnt > 0u ? cnt : 1u;
}

__device__ __forceinline__ void xcd_barrier(const XcdBarrier& b, const bool t0) {
    asm volatile("s_waitcnt vmcnt(0)" ::: "memory");
    __syncthreads();
    if (t0) {
        unsigned* bar = b.bar;
        __builtin_amdgcn_s_waitcnt(0);
        unsigned nloc = b.st[0], nx = b.st[1];
        if (nloc == 0u) { xcd_barrier_complete(bar, b.x, nloc, nx); b.st[0] = nloc; b.st[1] = nx; }
        const unsigned old = xb_add(&bar[XB_XSUB(b.x)], 1u);
        const unsigned gen = old / nloc;
        if (old + 1u == (gen + 1u) * nloc) {
            __builtin_amdgcn_fence(__ATOMIC_RELEASE, "agent");
            asm volatile("s_waitcnt vmcnt(0)" ::: "memory");
            const unsigned og = xb_add(&bar[XB_TOP], 1u);
            const unsigned tg = og / nx;
            if (og + 1u == (tg + 1u) * nx) xb_add(&bar[XB_TOPGEN], 1u);
            else XB_SPIN(xb_ld(&bar[XB_TOPGEN]) == tg, bar);
            __builtin_amdgcn_fence(__ATOMIC_ACQUIRE, "agent");
            xb_add(&bar[XB_XGEN(b.x)], 1u);
            asm volatile("s_waitcnt vmcnt(0)" ::: "memory");
        } else {
            XB_SPIN(xb_ld(&bar[XB_XGEN(b.x)]) == gen, bar);
            __builtin_amdgcn_fence(__ATOMIC_ACQUIRE, "agent");
            asm volatile("s_waitcnt vmcnt(0)" ::: "memory");
        }
    }
    __syncthreads();
}

struct Args { const float* in[25]; float* out; unsigned char* ws; int ph_lo, ph_hi; };
enum { I_X = 0, I_ANG, I_AINW, I_LRE, I_LIM, I_LOGDT, I_BRE, I_BIM, I_CRE, I_CIM, I_AD, I_GLUW, I_GLUB, I_AOUTW, I_KVG, I_KVW, I_BNG, I_BINW, I_LQ1, I_LK1, I_LQ2, I_LK2, I_SUBG, I_BOUTW, I_FG };

__device__ __forceinline__ void p0_transpose_item(const float* W, const float* gain, int K, int N, bf16* WT, int row_off, LAS float* scr, int item, int lane) {
    const int nblk = N / 32, kb = item / nblk, nb = item % nblk, k0 = 64 * kb, n0 = 32 * nb;
    float wv_[32];
#pragma unroll
    for (int i = 0; i < 32; ++i) wv_[i] = W[(size_t)(k0 + 2 * i + (lane >> 5)) * N + n0 + (lane & 31)];
    const float g0_ = gain ? gain[k0 + lane] : 1.0f;
#pragma unroll
    for (int i = 0; i < 32; ++i) { const int kk = 2 * i + (lane >> 5); const float gk = __shfl(g0_, kk); scr[kk * 33 + (lane & 31)] = gk * wv_[i]; }
    asm volatile("s_waitcnt lgkmcnt(0)" ::: "memory");
    const int c = lane & 7;
#pragma unroll
    for (int j = 0; j < 4; ++j) { const int n = (lane >> 3) + 8 * j; const LAS float* s = scr + (8 * c) * 33 + n;
        v4u o; o.x = pk2(s[0 * 33], s[1 * 33]); o.y = pk2(s[2 * 33], s[3 * 33]); o.z = pk2(s[4 * 33], s[5 * 33]); o.w = pk2(s[6 * 33], s[7 * 33]);
        *(v4u*)(WT + (size_t)(row_off + n0 + n) * K + k0 + 8 * c) = o; }
    asm volatile("s_waitcnt lgkmcnt(0)" ::: "memory");
}
__device__ __forceinline__ void p0_ssm_tables(const int wv, const Args& a, unsigned char* ws, LAS unsigned char* lds, int g, int qd) {
    const int tid = wv * 64 + pg8::lane_id();
    LAS float* pwr = (LAS float*)lds;
    LAS float* pwi = pwr + 33 * 64;
    LAS float* bbr = pwi + 33 * 64;
    LAS float* bbi = bbr + 1024;
    LAS float* ccr = bbi + 1024;
    LAS float* cci = ccr + 1024;
    const float* lam_re = a.in[I_LRE]; const float* lam_im = a.in[I_LIM]; const float* log_dt = a.in[I_LOGDT];
    const float dt = expf(log_dt[g]);
    { const int p = tid & 63; const float lr = lam_re[g * 64 + p], li = lam_im[g * 64 + p];
      for (int tau = tid >> 6; tau <= SSM_L; tau += 8) { const float mg = expf(lr * dt * (float)tau), an = li * dt * (float)tau; pwr[tau * 64 + p] = mg * cosf(an); pwi[tau * 64 + p] = mg * sinf(an); }
      const float mg = expf(lr * dt), an = li * dt, ar = mg * cosf(an), ai = mg * sinf(an);
      const float den = lr * lr + li * li, nr = ar - 1.0f, ni = ai, fr = (nr * lr + ni * li) / den, fi = (ni * lr - nr * li) / den;
      for (int j = tid >> 6; j < 16; j += 8) { const float br = a.in[I_BRE][(size_t)(g * 64 + p) * 16 + j], bi = a.in[I_BIM][(size_t)(g * 64 + p) * 16 + j]; bbr[p * 16 + j] = fr * br - fi * bi; bbi[p * 16 + j] = fr * bi + fi * br; }
      for (int i = tid >> 6; i < 16; i += 8) { ccr[i * 64 + p] = a.in[I_CRE][(size_t)(g * 16 + i) * 64 + p]; cci[i * 64 + p] = a.in[I_CIM][(size_t)(g * 16 + i) * 64 + p]; }
    }
    __syncthreads();
    unsigned char* tg = ws + WS_TAB + (size_t)g * TAB_STRIDE;
    bf16* bpt = (bf16*)(tg + TAB_BPT); bf16* cpt = (bf16*)(tg + TAB_CPT); bf16* kt = (bf16*)(tg + TAB_KT); float* al = (float*)(tg + TAB_AL);
    for (int e = qd * 16384 + tid; e < (qd + 1) * 16384; e += 512) { const int pp = e / KU, sj = e % KU, s = sj >> 4, j = sj & 15, p = pp & 63, tau = SSM_L - 1 - s;
        const float wr = pwr[tau * 64 + p], wi = pwi[tau * 64 + p], br = bbr[p * 16 + j], bi = bbi[p * 16 + j];
        bpt[e] = (bf16)f2bf(pp < 64 ? wr * br - wi * bi : wr * bi + wi * br); }
    for (int e = qd * 16384 + tid; e < (qd + 1) * 16384; e += 512) { const int ti = e >> 7, pp = e & 127, t = ti >> 4, i = ti & 15, p = pp & 63;
        const float wr = pwr[(t + 1) * 64 + p], wi = pwi[(t + 1) * 64 + p], cr = ccr[i * 64 + p], ci = cci[i * 64 + p];
        cpt[e] = (bf16)f2bf(pp < 64 ? cr * wr - ci * wi : -(cr * wi + ci * wr)); }
    for (int e = qd * 2112 + tid; e < (qd + 1) * 2112; e += 512) { const int t1 = e >> 8, rest = e & 255, hi = rest >> 7, i = (rest & 127) >> 3, j = hi * 8 + (rest & 7);
        float s = 0.f;
        if (t1 > 0) { const int tau = t1 - 1;
            for (int p = 0; p < 64; ++p) { const float wr = pwr[tau * 64 + p], wi = pwi[tau * 64 + p], br = bbr[p * 16 + j], bi = bbi[p * 16 + j];
                s += ccr[i * 64 + p] * (wr * br - wi * bi) - cci[i * 64 + p] * (wr * bi + wi * br); } }
        if (t1 == 1 && i == j) s += a.in[I_AD][g * 16 + i];
        kt[e] = (bf16)f2bf(s); }
    if (qd == 0 && tid < 128) al[tid] = tid < 64 ? pwr[SSM_L * 64 + tid] : pwi[SSM_L * 64 + tid - 64];
    __syncthreads();
}

__device__ __forceinline__ void ssm_phase(LAS unsigned char* lds, const bf16* U, bf16* YG, const unsigned char* tab, float* Eg, bf16* XPg, const float* dskip, int vcu, int G, const int wv) {
    const int wid = wv;
    for (int item = vcu; item < 256; item += G) {
        const int lane = pg8::lane_id_v(), tid = wv * 64 + lane, r32 = lane & 31, hi = lane >> 5;
        const int b = item >> 6, g = item & 63;
        const unsigned char* tg = tab + (size_t)g * TAB_STRIDE;
        const bf16* Ub = U + (size_t)item * T * 16;
        bf16* XP = XPg + (size_t)item * NCH * 128;
        const bf16* ua = Ub + (size_t)((wid * 32 + r32) * SSM_L) * 16 + hi * 8;
        {
            const unsigned char* gsrc = tg + TAB_BPT + (size_t)tid * 16; LAS unsigned char* ldst = lds + (tid >> 6) * 1040 + (tid & 63) * 16;
            for (int h2 = 0; h2 < 2; ++h2) { v4u tb[8];
#pragma unroll
                for (int k = 0; k < 8; ++k) tb[k] = *(const v4u*)(gsrc + k * 8192);
#pragma unroll
                for (int k = 0; k < 8; ++k) *(LAS v4u*)(ldst + k * 8320) = tb[k];
                gsrc += 65536; ldst += 8 * 8320; } }
        __syncthreads();
        {
            f32x16 acc[4];
#pragma unroll
            for (int n = 0; n < 4; ++n) acc[n] = f32x16{};
            const LAS unsigned char* bb = lds + r32 * 1040 + hi * 16;
            bf16x8 uc[8];
#pragma unroll
            for (int j = 0; j < 8; ++j) uc[j] = *(const bf16x8*)(ua + (size_t)j * 16);
            for (int bt = 0; bt < 4; ++bt) {
                bf16x8 un[8];
                if (bt < 3) {
#pragma unroll
                    for (int j = 0; j < 8; ++j) un[j] = *(const bf16x8*)(ua + (size_t)(8 * bt + 8 + j) * 16); }
                const LAS unsigned char* bq = bb + bt * 256;
                bf16x8 bc[4], bn[4];
#pragma unroll
                for (int n = 0; n < 4; ++n) bc[n] = *(const LAS bf16x8*)(bq + n * 32 * 1040);
#pragma unroll
                for (int j = 0; j < 8; ++j) {
                    if (j < 7) {
#pragma unroll
                        for (int n = 0; n < 4; ++n) bn[n] = *(const LAS bf16x8*)(bq + n * 32 * 1040 + (j + 1) * 32); }
#pragma unroll
                    for (int n = 0; n < 4; ++n) acc[n] = __builtin_amdgcn_mfma_f32_32x32x16_bf16(uc[j], bc[n], acc[n], 0, 0, 0);
                    if (j < 7) {
#pragma unroll
                        for (int n = 0; n < 4; ++n) bc[n] = bn[n]; }
                }
                if (bt < 3) {
#pragma unroll
                    for (int j = 0; j < 8; ++j) uc[j] = un[j]; }
            }
            __syncthreads();
            LAS float* El = (LAS float*)lds;
#pragma unroll
            for (int n = 0; n < 4; ++n)
#pragma unroll
                for (int r = 0; r < 16; ++r) El[(wid * 32 + crow(r, hi)) * 128 + n * 32 + r32] = acc[n][r];
        }
        __syncthreads();
        {
            const float* al = (const float*)(tg + TAB_AL); const float ar = al[lane], ai = al[64 + lane];
            const LAS float* ep = (const LAS float*)lds + (wid * 32) * 128 + lane;
            float xr = 0.f, xi = 0.f;
            for (int kb = 0; kb < 4; ++kb) { float er[8], ei[8];
#pragma unroll
                for (int k = 0; k < 8; ++k) { er[k] = ep[k * 128]; ei[k] = ep[k * 128 + 64]; }
#pragma unroll
                for (int k = 0; k < 8; ++k) { const float nr = ar * xr - ai * xi + er[k], ni = ar * xi + ai * xr + ei[k]; xr = nr; xi = ni; }
                ep += 8 * 128; }
            LAS float* sg = (LAS float*)(lds + 131072);
            sg[(wid * 64 + lane) * 2] = xr; sg[(wid * 64 + lane) * 2 + 1] = xi;
            __syncthreads();
            float pr = ar, pi = ai;
#pragma unroll
            for (int k = 0; k < 5; ++k) { const float nr = pr * pr - pi * pi, ni = 2.0f * pr * pi; pr = nr; pi = ni; }
            float sr = 0.f, si = 0.f;
            for (int s2 = 0; s2 < wid; ++s2) { const float zr = sg[(s2 * 64 + lane) * 2], zi = sg[(s2 * 64 + lane) * 2 + 1]; const float nr = pr * sr - pi * si + zr, ni = pr * si + pi * sr + zi; sr = nr; si = ni; }
            xr = sr; xi = si;
            ep = (const LAS float*)lds + (wid * 32) * 128 + lane; bf16* xp = XP + (size_t)(wid * 32) * 128 + lane;
            for (int kb = 0; kb < 4; ++kb) { float er[8], ei[8];
#pragma unroll
                for (int k = 0; k < 8; ++k) { er[k] = ep[k * 128]; ei[k] = ep[k * 128 + 64]; }
#pragma unroll
                for (int k = 0; k < 8; ++k) { xp[k * 128] = (bf16)f2bf(xr); xp[k * 128 + 64] = (bf16)f2bf(xi);
                    const float nr = ar * xr - ai * xi + er[k], ni = ar * xi + ai * xr + ei[k]; xr = nr; xi = ni; }
                ep += 8 * 128; xp += 8 * 128; }
        }
        __syncthreads();
        constexpr int KT_LDS = 256 * 272;
        for (int half = 0; half < 2; ++half) {
            {   v4u tb[8], tk[3];
                const unsigned char* gsrc = tg + TAB_CPT + (size_t)half * 65536 + (size_t)tid * 16; LAS unsigned char* ldst = lds + (tid >> 4) * 272 + (tid & 15) * 16;
                const unsigned char* ksrc = tg + TAB_KT + (size_t)tid * 16; LAS unsigned char* kdst = lds + KT_LDS + tid * 16;
#pragma unroll
                for (int k = 0; k < 8; ++k) tb[k] = *(const v4u*)(gsrc + k * 8192);
                if (half == 0) { tk[0] = *(const v4u*)ksrc; tk[1] = *(const v4u*)(ksrc + 8192); if (tid < 32) tk[2] = *(const v4u*)(ksrc + 16384); }
#pragma unroll
                for (int k = 0; k < 8; ++k) *(LAS v4u*)(ldst + k * 8704) = tb[k];
                if (half == 0) { *(LAS v4u*)kdst = tk[0]; *(LAS v4u*)(kdst + 8192) = tk[1]; if (tid < 32) *(LAS v4u*)(kdst + 16384) = tk[2]; } }
            __syncthreads();
            for (int qq = 0; qq < 2; ++qq) {
                const int q = half * 2 + qq;
                f32x16 acc[4];
#pragma unroll
                for (int n = 0; n < 4; ++n) acc[n] = f32x16{};
                const LAS unsigned char* kb = lds + KT_LDS + (r32 >> 4) * 512 + hi * 256 + (r32 & 15) * 16;
                const bf16* xa = XP + (size_t)(wid * 32 + r32) * 128 + hi * 8;
                const LAS unsigned char* cb = lds + (qq * 128 + r32) * 272 + hi * 16;
                bf16x8 uc[8];
#pragma unroll
                for (int j = 0; j < 8; ++j) uc[j] = *(const bf16x8*)(ua + (size_t)j * 16);
                for (int bt = 0; bt < q; ++bt) {
                    bf16x8 un[8];
#pragma unroll
                    for (int j = 0; j < 8; ++j) un[j] = *(const bf16x8*)(ua + (size_t)(8 * bt + 8 + j) * 16);
                    const LAS unsigned char* kq = kb + (8 * (q - bt) + 1) * 512;
                    bf16x8 bc[4], bn[4];
#pragma unroll
                    for (int n = 0; n < 4; ++n) bc[n] = *(const LAS bf16x8*)(kq + (2 * n) * 512);
#pragma unroll
                    for (int j = 0; j < 8; ++j) {
                        if (j < 7) {
#pragma unroll
                            for (int n = 0; n < 4; ++n) bn[n] = *(const LAS bf16x8*)(kq + (2 * n - (j + 1)) * 512); }
#pragma unroll
                        for (int n = 0; n < 4; ++n) acc[n] = __builtin_amdgcn_mfma_f32_32x32x16_bf16(bc[n], uc[j], acc[n], 0, 0, 0);
                        if (j < 7) {
#pragma unroll
                            for (int n = 0; n < 4; ++n) bc[n] = bn[n]; }
                    }
#pragma unroll
                    for (int j = 0; j < 8; ++j) uc[j] = un[j];
                }
#pragma unroll
                for (int j = 0; j < 8; ++j) {
                    bf16x8 bd[4];
#pragma unroll
                    for (int n = 0; n < 4; ++n) if (j <= 2 * n + 1) bd[n] = *(const LAS bf16x8*)(kb + (2 * n - j + 1) * 512);
#pragma unroll
                    for (int n = 0; n < 4; ++n) if (j <= 2 * n + 1) acc[n] = __builtin_amdgcn_mfma_f32_32x32x16_bf16(bd[n], uc[j], acc[n], 0, 0, 0);
                }
                {   bf16x8 bc[4], bn[4];
                    bf16x8 xv[8];
#pragma unroll
                    for (int ks = 0; ks < 8; ++ks) xv[ks] = *(const bf16x8*)(xa + ks * 16);
#pragma unroll
                    for (int n = 0; n < 4; ++n) bc[n] = *(const LAS bf16x8*)(cb + n * 32 * 272);
#pragma unroll
                    for (int ks = 0; ks < 8; ++ks) {
                        if (ks < 7) {
#pragma unroll
                            for (int n = 0; n < 4; ++n) bn[n] = *(const LAS bf16x8*)(cb + n * 32 * 272 + (ks + 1) * 32); }
#pragma unroll
                        for (int n = 0; n < 4; ++n) acc[n] = __builtin_amdgcn_mfma_f32_32x32x16_bf16(bc[n], xv[ks], acc[n], 0, 0, 0);
                        if (ks < 7) {
#pragma unroll
                            for (int n = 0; n < 4; ++n) bc[n] = bn[n]; }
                    }
                }
                const size_t rbase = ((size_t)b * T + (size_t)(wid * 32 + r32) * SSM_L) * 1024 + g * 16 + 8 * hi;
#pragma unroll
                for (int n = 0; n < 4; ++n)
#pragma unroll
                    for (int ap = 0; ap < 2; ++ap) { const int a0 = 2 * ap, a1 = 2 * ap + 1;
                        const f32x2 xa = gelu_pk((f32x2){acc[n][4 * a0 + 0], acc[n][4 * a0 + 1]}), xb = gelu_pk((f32x2){acc[n][4 * a0 + 2], acc[n][4 * a0 + 3]});
                        const f32x2 ya = gelu_pk((f32x2){acc[n][4 * a1 + 0], acc[n][4 * a1 + 1]}), yb = gelu_pk((f32x2){acc[n][4 * a1 + 2], acc[n][4 * a1 + 3]});
                        const auto r0 = __builtin_amdgcn_permlane32_swap(pk2(xa.x, xa.y), pk2(ya.x, ya.y), false, false);
                        const auto r1 = __builtin_amdgcn_permlane32_swap(pk2(xb.x, xb.y), pk2(yb.x, yb.y), false, false);
                        v4u w; w.x = r0[0]; w.y = r1[0]; w.z = r0[1]; w.w = r1[1];
                        *(v4u*)(YG + rbase + (size_t)(8 * q + 2 * n + ap) * 1024) = w; }
            }
            __syncthreads();
        }
    }
}

struct DumbEpi { int kind; int pad; bf16 *o0, *o1, *o2, *o3; const bf16 *i0, *i1; const float* f0; const float* f1; float* fo; };
__device__ __forceinline__ float pss_rinv(const float* PSS, int row) { float s = 0.f; for (int k = 0; k < 16; ++k) s += PSS[(size_t)row * 16 + k]; return 1.0f / sqrtf(s * (1.0f / 1024.0f) + NORM_EPS); }
__device__ __forceinline__ void dumb_epi(const DumbEpi& e, int row, int col, float v) {
    const size_t off = (size_t)row * 1024;
    if (e.kind == 1) { v *= e.f0[row]; if (col < 1024) e.o0[off + col] = (bf16)f2bf(v); else e.o1[off + col - 1024] = (bf16)f2bf(pg8::silu_f(v)); }
    else if (e.kind == 3) { const float t = v + e.f0[col]; e.o0[off + col] = (bf16)f2bf(bf2f(e.i0[off + col]) * pg8::sigm_f(t) * bf2f(e.i1[off + col])); }
    else if (e.kind == 4) { const float h = e.f0[off + col] + v; e.fo[off + col] = h; if (e.o0) e.o0[off + col] = (bf16)f2bf(h); }
    else if (e.kind == 5) { v *= pss_rinv(e.f0, row); const int seg = col >> 10, c = col & 1023;
        if (seg == 0) e.o0[off + c] = (bf16)f2bf(v); else if (seg == 1) e.o1[off + c] = (bf16)f2bf(v); else if (seg == 2) e.o2[off + c] = (bf16)f2bf(v * QSCALE); else e.o3[off + c] = (bf16)f2bf(pg8::silu_f(v)); }
}
__global__ void __launch_bounds__(256) dumb_gemm(const bf16* A, const bf16* Bt, int N, int K, DumbEpi e) {
    __shared__ float As[32][65], Bs[32][65];
    const int tid = threadIdx.x, tx = tid & 15, ty = tid >> 4, m0 = blockIdx.y * 64, n0 = blockIdx.x * 64;
    float acc[4][4];
#pragma unroll
    for (int i = 0; i < 4; ++i)
#pragma unroll
        for (int j = 0; j < 4; ++j) acc[i][j] = 0.f;
    const int lr = tid >> 2, lk = (tid & 3) * 8;
    for (int k0 = 0; k0 < K; k0 += 32) {
        const v4u av = *(const v4u*)(A + (size_t)(m0 + lr) * K + k0 + lk), bv = *(const v4u*)(Bt + (size_t)(n0 + lr) * K + k0 + lk);
        As[lk + 0][lr] = pg8::bf_lo(av.x); As[lk + 1][lr] = pg8::bf_hi(av.x); As[lk + 2][lr] = pg8::bf_lo(av.y); As[lk + 3][lr] = pg8::bf_hi(av.y);
        As[lk + 4][lr] = pg8::bf_lo(av.z); As[lk + 5][lr] = pg8::bf_hi(av.z); As[lk + 6][lr] = pg8::bf_lo(av.w); As[lk + 7][lr] = pg8::bf_hi(av.w);
        Bs[lk + 0][lr] = pg8::bf_lo(bv.x); Bs[lk + 1][lr] = pg8::bf_hi(bv.x); Bs[lk + 2][lr] = pg8::bf_lo(bv.y); Bs[lk + 3][lr] = pg8::bf_hi(bv.y);
        Bs[lk + 4][lr] = pg8::bf_lo(bv.z); Bs[lk + 5][lr] = pg8::bf_hi(bv.z); Bs[lk + 6][lr] = pg8::bf_lo(bv.w); Bs[lk + 7][lr] = pg8::bf_hi(bv.w);
        __syncthreads();
#pragma unroll 8
        for (int kk = 0; kk < 32; ++kk) { float a[4], b[4];
#pragma unroll
            for (int i = 0; i < 4; ++i) { a[i] = As[kk][ty * 4 + i]; b[i] = Bs[kk][tx * 4 + i]; }
#pragma unroll
            for (int i = 0; i < 4; ++i)
#pragma unroll
                for (int j = 0; j < 4; ++j) acc[i][j] += a[i] * b[j]; }
        __syncthreads();
    }
#pragma unroll
    for (int i = 0; i < 4; ++i)
#pragma unroll
        for (int j = 0; j < 4; ++j) dumb_epi(e, m0 + ty * 4 + i, n0 + tx * 4 + j, acc[i][j]);
}
__global__ void __launch_bounds__(256) dumb_rowss(const float* H, float* PSS) {
    const int row = blockIdx.x * 4 + (threadIdx.x >> 6), lane = threadIdx.x & 63; float s = 0.f;
    for (int c = lane; c < 1024; c += 64) { const float v = H[(size_t)row * 1024 + c]; s += v * v; }
    s = wave_sum(s); if (lane < 16) PSS[(size_t)row * 16 + lane] = lane == 0 ? s : 0.f;
}
__global__ void __launch_bounds__(256) dumb_rope(bf16* X, const float* rc, const float* rs) {
    const size_t idx = (size_t)blockIdx.x * 256 + threadIdx.x;
    const int i = idx & 7, h = (idx >> 3) & 15; const size_t row = idx >> 7; const int pos = (int)(row & 8191);
    bf16* p = X + row * 1024 + h * 64 + i; const float x1 = bf2f(p[0]), x2 = bf2f(p[8]), c = rc[pos * 8 + i], s = rs[pos * 8 + i];
    p[0] = (bf16)f2bf(x1 * c - x2 * s); p[8] = (bf16)f2bf(x2 * c + x1 * s);
}
__global__ void __launch_bounds__(64) dumb_ssm(const bf16* U, bf16* YG, const float* lam_re, const float* lam_im, const float* log_dt, const float* b_re, const float* b_im,
                                               const float* c_re, const float* c_im, const float* d_skip) {
    const int item = blockIdx.x, b = item >> 6, g = item & 63, p = threadIdx.x;
    const float dt = expf(log_dt[g]), lr = lam_re[g * 64 + p], li = lam_im[g * 64 + p];
    const float mg = expf(lr * dt), an = li * dt, ar = mg * cosf(an), ai = mg * sinf(an);
    const float den = lr * lr + li * li, nr = ar - 1.0f, ni = ai, fr = (nr * lr + ni * li) / den, fi = (ni * lr - nr * li) / den;
    float bbr[16], bbi[16], cr[16], ci[16];
#pragma unroll
    for (int j = 0; j < 16; ++j) { const float br = b_re[(size_t)(g * 64 + p) * 16 + j], bi = b_im[(size_t)(g * 64 + p) * 16 + j]; bbr[j] = fr * br - fi * bi; bbi[j] = fr * bi + fi * br;
        cr[j] = c_re[(size_t)(g * 16 + j) * 64 + p]; ci[j] = c_im[(size_t)(g * 16 + j) * 64 + p]; }
    const float dv = d_skip[g * 16 + (p & 15)];
    float xr = 0.f, xi = 0.f;
    for (int t = 0; t < T; ++t) {
        const bf16* up = U + ((size_t)b * T + t) * 1024 + g * 16;
        const v4u w0 = *(const v4u*)up, w1 = *(const v4u*)(up + 8);
        float uu[16];
        uu[0] = pg8::bf_lo(w0.x); uu[1] = pg8::bf_hi(w0.x); uu[2] = pg8::bf_lo(w0.y); uu[3] = pg8::bf_hi(w0.y); uu[4] = pg8::bf_lo(w0.z); uu[5] = pg8::bf_hi(w0.z); uu[6] = pg8::bf_lo(w0.w); uu[7] = pg8::bf_hi(w0.w);
        uu[8] = pg8::bf_lo(w1.x); uu[9] = pg8::bf_hi(w1.x); uu[10] = pg8::bf_lo(w1.y); uu[11] = pg8::bf_hi(w1.y); uu[12] = pg8::bf_lo(w1.z); uu[13] = pg8::bf_hi(w1.z); uu[14] = pg8::bf_lo(w1.w); uu[15] = pg8::bf_hi(w1.w);
        float bur = 0.f, bui = 0.f;
#pragma unroll
        for (int j = 0; j < 16; ++j) { bur += bbr[j] * uu[j]; bui += bbi[j] * uu[j]; }
        const float n_r = ar * xr - ai * xi + bur, n_i = ar * xi + ai * xr + bui; xr = n_r; xi = n_i;
        float myy = 0.f;
#pragma unroll
        for (int i = 0; i < 16; ++i) { const float s = wave_sum(cr[i] * xr - ci[i] * xi); if (p == i) myy = s; }
        if (p < 16) { const float y = myy + dv * bf2f(up[p]); YG[((size_t)b * T + t) * 1024 + g * 16 + p] = (bf16)f2bf(gelu_erf(y)); }
    }
}
__global__ void __launch_bounds__(128) dumb_attn(const bf16* Q, const bf16* K, const bf16* V, bf16* O1, bf16* O2) {
    __shared__ float sc[T]; __shared__ float red[2]; __shared__ float qs[64];
    const int q = blockIdx.x, vh = blockIdx.y, b = blockIdx.z, t = threadIdx.x, lane = t & 63, w = t >> 6;
    const size_t row = (size_t)b * T + q;
    if (t < 64) qs[t] = bf2f(Q[row * 1024 + vh * 64 + t]);
    __syncthreads();
    float mx = -INFINITY;
    for (int k = t; k <= q; k += 128) { const bf16* kp = K + ((size_t)b * T + k) * 1024 + vh * 64; float s = 0.f;
        for (int d = 0; d < 64; d += 8) { const v4u kv = *(const v4u*)(kp + d);
            s += qs[d] * pg8::bf_lo(kv.x) + qs[d + 1] * pg8::bf_hi(kv.x) + qs[d + 2] * pg8::bf_lo(kv.y) + qs[d + 3] * pg8::bf_hi(kv.y) + qs[d + 4] * pg8::bf_lo(kv.z) + qs[d + 5] * pg8::bf_hi(kv.z) + qs[d + 6] * pg8::bf_lo(kv.w) + qs[d + 7] * pg8::bf_hi(kv.w); }
        sc[k] = s; mx = fmaxf(mx, s); }
#pragma unroll
    for (int o = 1; o < 64; o <<= 1) mx = fmaxf(mx, __shfl_xor(mx, o));
    if (lane == 0) red[w] = mx;
    __syncthreads();
    mx = fmaxf(red[0], red[1]);
    __syncthreads();
    float sum = 0.f;
    for (int k = t; k <= q; k += 128) { const float pv = exp2f(sc[k] - mx); sc[k] = pv; sum += pv; }
    sum = wave_sum(sum);
    if (lane == 0) red[w] = sum;
    __syncthreads();
    sum = red[0] + red[1];
    const int h = vh >> 1; float o = 0.f;
    for (int k = 0; k <= q; ++k) o += sc[k] * bf2f(V[((size_t)b * T + k) * 1024 + h * 128 + t]);
    bf16* O = (vh & 1) ? O2 : O1; O[row * 1024 + h * 128 + t] = (bf16)f2bf(o / sum);
}

__global__ void __launch_bounds__(NWAVES * 64, 2) mega(Args args) {
    extern __shared__ __attribute__((aligned(16))) unsigned char lds_raw[];
    LAS unsigned char* lds = (LAS unsigned char*)lds_raw;
    const int wave = __builtin_amdgcn_readfirstlane(threadIdx.x >> 6);
#define lane (pg8::lane_id())
#define tid (wave * 64 + pg8::lane_id())
    const int G = gridDim.x; const int bx = blockIdx.x; const int vcu = (G % 8 == 0) ? (bx % 8) * (G / 8) + bx / 8 : bx;
#define ws (args.ws)
    const int lo = args.ph_lo, hi = args.ph_hi;
    volatile LAS unsigned* MISC = (volatile LAS unsigned*)(lds + MISC_OFF);
    XcdBarrier xbar; xbar.bar = (unsigned*)(ws + WS_CTL) + 4096; xbar.x = 0; xbar.st = nullptr;
    if (lo < -1000) cg::this_grid().sync();
    if (hi - lo > 1) { if (pg8::lane_id() < 16 && wave == 0) MISC[pg8::lane_id()] = 0u; __syncthreads(); xbar = xcd_barrier_post((unsigned*)(ws + WS_CTL) + 4096, MISC + 8, wave == 0 && pg8::lane_id() == 0); }
#ifndef CFG_SKIP
#define CFG_SKIP 0
#endif
#define IN(k) (lo <= (k) && (k) < hi && !((CFG_SKIP >> (k)) & 1))
#ifndef CFG_REP_MASK
#define CFG_REP_MASK 0
#endif
#define REPS(k) (IN(k) ? 1 + ((CFG_REP_MASK >> (k)) & 1) : 0)
#define SEAM(k) do { if (IN(k) && IN((k) + 1)) { xcd_barrier(xbar, tid == 0); } } while (0)
#define WIN ((bf16*)(ws + WS_WIN))
#define WGLU ((bf16*)(ws + WS_WGLU))
#define WOUT ((bf16*)(ws + WS_WOUT))
#define WKVQ ((bf16*)(ws + WS_WKVQ))
#define WBO ((bf16*)(ws + WS_WBO))
#define ropec ((float*)(ws + WS_ROPE))
#define ropes ((float*)(ws + WS_ROPE + 256 * 1024))
#define rinv0 ((float*)(ws + WS_RINV0))
#define lamv ((float*)(ws + WS_LAM))
#define PSS1 ((float*)(ws + WS_PSS1))
#define PSS2 ((float*)(ws + WS_PSS2))
#define XB ((bf16*)(ws + WS_S0))
#define YG ((bf16*)(ws + WS_S0))
#define H1B ((bf16*)OUTP)
#define H2B ((bf16*)(ws + WS_S3))
#define O1 ((bf16*)(ws + WS_S0))
#define U ((bf16*)(ws + WS_S1))
#define Y2 ((bf16*)(ws + WS_S1))
#define KB ((bf16*)(ws + WS_S1))
#define A2 ((bf16*)(ws + WS_S5))
#define ZG ((bf16*)(ws + WS_S2))
#define VB ((bf16*)(ws + WS_S2))
#define QB ((bf16*)(ws + WS_S3))
#define ZG2 ((bf16*)(ws + WS_S4))
#define O2 ((bf16*)(ws + WS_S5))
#define XIN (args.in[I_X])
#define OUTP (args.out)
#define gw (vcu * NWAVES + wave)
#define NGW (G * NWAVES)

    for (int rep_ = 0; rep_ < REPS(0); ++rep_) {
        LAS float* scr = (LAS float*)(lds + wave * 16384);
        constexpr int I_1 = 16 * 64, I_2 = 16 * 32;
        constexpr int NITEMS = 3 * I_1 + 3 * I_2;
        for (int it = gw; it < NITEMS; it += NGW) {
            int r = it;
            if (r < I_1) { p0_transpose_item(args.in[I_AINW], args.in[I_ANG], D, 2048, WIN, 0, scr, r, lane); continue; } r -= I_1;
            if (r < I_1) { p0_transpose_item(args.in[I_KVW], args.in[I_KVG], D, 2048, WKVQ, 0, scr, r, lane); continue; } r -= I_1;
            if (r < I_1) { p0_transpose_item(args.in[I_BINW], args.in[I_BNG], D, 2048, WKVQ, 2048, scr, r, lane); continue; } r -= I_1;
            if (r < I_2) { p0_transpose_item(args.in[I_GLUW], nullptr, D, 1024, WGLU, 0, scr, r, lane); continue; } r -= I_2;
            if (r < I_2) { p0_transpose_item(args.in[I_AOUTW], nullptr, D, 1024, WOUT, 0, scr, r, lane); continue; } r -= I_2;
            p0_transpose_item(args.in[I_BOUTW], nullptr, D, 1024, WBO, 0, scr, r, lane);
        }
        for (int m0 = gw; m0 < M; m0 += 4 * NGW) {
            f32x4 v[4][4];
#pragma unroll
            for (int k = 0; k < 4; ++k) { const int m = m0 + k * NGW; if (m < M) { const f32x4* xr = (const f32x4*)(XIN + (size_t)m * D) + lane;
#pragma unroll
                for (int j = 0; j < 4; ++j) v[k][j] = xr[64 * j]; } }
#pragma unroll
            for (int k = 0; k < 4; ++k) { const int m = m0 + k * NGW; if (m < M) { float s = 0.f;
#pragma unroll
                for (int j = 0; j < 4; ++j) s += (v[k][j].x * v[k][j].x + v[k][j].y * v[k][j].y) + (v[k][j].z * v[k][j].z + v[k][j].w * v[k][j].w);
                s = wave_sum(s); if (lane == 0) rinv0[m] = 1.0f / sqrtf(s * (1.0f / D) + NORM_EPS);
                unsigned long long* o8 = (unsigned long long*)(XB + (size_t)m * D) + lane;
#pragma unroll
                for (int j = 0; j < 4; ++j) o8[64 * j] = (unsigned long long)pk2(v[k][j].x, v[k][j].y) | ((unsigned long long)pk2(v[k][j].z, v[k][j].w) << 32); } }
        }
        for (int e = vcu * 512 + tid; e < T * 8; e += G * 512) { const int pos = e >> 3, i = e & 7; const float inv = powf(500000.0f, -(float)i / 8.0f); const float an = (float)pos * inv; ropec[e] = cosf(an); ropes[e] = sinf(an); }
        if (bx == 0 && wave == 0) { const float a1 = wave_sum(args.in[I_LQ1][lane] * args.in[I_LK1][lane]), a2 = wave_sum(args.in[I_LQ2][lane] * args.in[I_LK2][lane]); if (lane == 0) lamv[0] = expf(a1) - expf(a2) + LAM_INIT; }
        __syncthreads();
        for (int it = vcu; it < 256; it += G) p0_ssm_tables(wave, args, ws, lds, it >> 2, it & 3);
    }
    SEAM(0);
    for (int rep_ = 0; rep_ < REPS(1); ++rep_) {
        pg8::Gemm g{XB, WIN, M, 2048, D}; pg8::StaticOrder S; S.init(M, 2048, G, bx);
        pg8::EpiUZ E{U, ZG, rinv0};
        pg8::gemm_phase<pg8::EpiUZ, pg8::StaticOrder, true, true>(wave, lds, g, S, E);
    }
    SEAM(1);
    for (int rep_ = 0; rep_ < REPS(2); ++rep_) ssm_phase(lds, U, YG, ws + WS_TAB, (float*)(ws + WS_E), (bf16*)(ws + WS_XP), args.in[I_AD], vcu, G, wave);
    SEAM(2);
    for (int rep_ = 0; rep_ < REPS(3); ++rep_) {
        pg8::Gemm g{YG, WGLU, M, 1024, D}; pg8::StaticOrder S; S.init(M, 1024, G, bx);
        pg8::EpiGlu E{YG, ZG, args.in[I_GLUB], Y2};
        pg8::gemm_phase<pg8::EpiGlu, pg8::StaticOrder, true, true>(wave, lds, g, S, E);
    }
    SEAM(3);
    for (int rep_ = 0; rep_ < REPS(4); ++rep_) {
        pg8::Gemm g{Y2, WOUT, M, 1024, D}; pg8::StaticOrder S; S.init(M, 1024, G, bx);
        pg8::EpiRes<false> E{XIN, H1B, PSS1};
        pg8::gemm_phase<pg8::EpiRes<false>, pg8::StaticOrder, true, true>(wave, lds, g, S, E);
    }
    SEAM(4);
    for (int rep_ = 0; rep_ < REPS(5); ++rep_) {
        pg8::Gemm g{H1B, WKVQ, M, 4096, D}; pg8::StaticOrder S; S.init(M, 4096, G, bx);
        pg8::EpiKVQZ E{KB, VB, QB, ZG2, PSS1, ropec, ropes, QSCALE};
        pg8::gemm_phase<pg8::EpiKVQZ, pg8::StaticOrder, true, true>(wave, lds, g, S, E);
    }
    SEAM(5);
    for (int rep_ = 0; rep_ < REPS(6); ++rep_) {
        const attn_body::AttnTensors AT{(const attn_body::bf16*)QB, (const attn_body::bf16*)KB, (const attn_body::bf16*)VB, (attn_body::bf16*)O1};
        const attn_body::Comb CA{(const attn_body::bf16*)ZG2, (attn_body::bf16*)A2, args.in[I_SUBG], lamv[0], 1.0f - LAM_INIT};
        const attn_body::StaticOrder S(G, bx);
        attn_body::attn_phase<attn_body::StaticOrder>(wave, (char*)lds_raw, AT, CA, S);
    }
    if (IN(6) && IN(8)) xcd_barrier(xbar, tid == 0);
    for (int rep_ = 0; rep_ < REPS(8); ++rep_) {
        pg8::Gemm g{A2, WBO, M, 1024, D}; pg8::StaticOrder S; S.init(M, 1024, G, bx);
        pg8::EpiRes<true> E{H1B, H2B, PSS2};
        pg8::gemm_phase<pg8::EpiRes<true>, pg8::StaticOrder, true, true>(wave, lds, g, S, E);
    }
    SEAM(8);
#ifndef CFG_EXTRA_SYNC
#define CFG_EXTRA_SYNC 0
#endif
    if (IN(8) && IN(9)) for (int es_ = 0; es_ < CFG_EXTRA_SYNC; ++es_) cg::this_grid().sync();
    for (int rep_ = 0; rep_ < REPS(9); ++rep_) {
        const float* fg = args.in[I_FG];
        const f32x4* gr = (const f32x4*)fg + 4 * lane; const f32x4 g0 = gr[0], g1 = gr[1], g2 = gr[2], g3 = gr[3];
        for (int m0 = gw; m0 < M; m0 += 4 * NGW) {
            v4u h0[4], h1[4]; float ps[4];
#pragma unroll
            for (int k = 0; k < 4; ++k) { const int m = m0 + k * NGW; if (m < M) { h0[k] = *((const v4u*)(H2B + (size_t)m * D) + 2 * lane); h1[k] = *((const v4u*)(H2B + (size_t)m * D) + 2 * lane + 1); ps[k] = lane < 16 ? PSS2[(size_t)m * 16 + lane] : 0.f; } }
#pragma unroll
            for (int k = 0; k < 4; ++k) { const int m = m0 + k * NGW; if (m < M) { const float ri = 1.0f / sqrtf(wave_sum(ps[k]) * (1.0f / D) + NORM_EPS);
                f32x4* orow = (f32x4*)(OUTP + (size_t)m * D) + 4 * lane;
                orow[0] = (f32x4){pg8::bf_lo(h0[k].x), pg8::bf_hi(h0[k].x), pg8::bf_lo(h0[k].y), pg8::bf_hi(h0[k].y)} * ri * g0;
                orow[1] = (f32x4){pg8::bf_lo(h0[k].z), pg8::bf_hi(h0[k].z), pg8::bf_lo(h0[k].w), pg8::bf_hi(h0[k].w)} * ri * g1;
                orow[2] = (f32x4){pg8::bf_lo(h1[k].x), pg8::bf_hi(h1[k].x), pg8::bf_lo(h1[k].y), pg8::bf_hi(h1[k].y)} * ri * g2;
                orow[3] = (f32x4){pg8::bf_lo(h1[k].z), pg8::bf_hi(h1[k].z), pg8::bf_lo(h1[k].w), pg8::bf_hi(h1[k].w)} * ri * g3; } }
        }
    }
#undef IN
#undef SEAM
#undef REPS
#undef WIN
#undef WGLU
#undef WOUT
#undef WKVQ
#undef WBO
#undef ropec
#undef ropes
#undef rinv0
#undef lamv
#undef PSS1
#undef PSS2
#undef XB
#undef YG
#undef H1B
#undef H2B
#undef O1
#undef U
#undef Y2
#undef KB
#undef A2
#undef ZG
#undef VB
#undef QB
#undef ZG2
#undef O2
#undef lane
#undef tid
#undef XIN
#undef OUTP
#undef gw
#undef NGW
#undef ws
}

static void launch_mega(int grid, Args a, int lo, int hi, bool coop, hipStream_t stream) {
    a.ph_lo = lo; a.ph_hi = hi;
    if (coop) { void* kargs[] = {&a}; hipError_t e = hipLaunchCooperativeKernel((const void*)mega, dim3(grid), dim3(NWAVES * 64), kargs, LDS_BYTES, stream);
        if (e != hipSuccess) fprintf(stderr, "kernel_launch: cooperative launch failed: %s (grid %d)\n", hipGetErrorString(e), grid); }
    else hipLaunchKernelGGL(mega, dim3(grid), dim3(NWAVES * 64), LDS_BYTES, stream, a);
}
extern "C" void kernel_launch(void* const* d_in, const int* in_sizes, int n_in, void* d_out, int out_size, void* d_ws, size_t ws_size, hipStream_t stream) {
    static int grid = 0;
    if (grid == 0) {
        if (n_in != 25 || in_sizes[0] != M * D || out_size != M * D || ws_size < WS_END) { fprintf(stderr, "kernel_launch: unexpected shapes (n_in %d, in0 %d, out %d, ws %zu); nothing launched\n", n_in, n_in > 0 ? in_sizes[0] : -1, out_size, ws_size); grid = -1; return; }
        int dev = 0, cus = 0, per_cu = 0;
        if (hipGetDevice(&dev) != hipSuccess || hipDeviceGetAttribute(&cus, hipDeviceAttributeMultiprocessorCount, dev) != hipSuccess) { grid = -1; return; }
        if (hipFuncSetAttribute((const void*)mega, hipFuncAttributeMaxDynamicSharedMemorySize, LDS_BYTES) != hipSuccess) { fprintf(stderr, "kernel_launch: hipFuncSetAttribute failed\n"); grid = -1; return; }
        if (hipOccupancyMaxActiveBlocksPerMultiprocessor(&per_cu, (const void*)mega, NWAVES * 64, LDS_BYTES) != hipSuccess || per_cu < 1) { fprintf(stderr, "kernel_launch: occupancy query gave %d\n", per_cu); per_cu = 1; }
        (void)hipGetLastError();
        if (per_cu > 1) per_cu = 1;
        grid = cus * per_cu;
    }
    if (grid < 0) return;
    Args a{};
    for (int i = 0; i < 25; ++i) a.in[i] = (const float*)d_in[i];
    a.out = (float*)d_out; a.ws = (unsigned char*)d_ws;
    unsigned char* ws = (unsigned char*)d_ws;
#if CFG_SINGLE && (CFG_DUMB_MASK == 0)
    if (hipMemsetAsync((char*)d_ws + WS_CTL, 0, 65536, stream) != hipSuccess) { fprintf(stderr, "kernel_launch: memset failed\n"); return; }
    launch_mega(grid, a, 0, NPHASE, true, stream);
#else
    bf16 *S0 = (bf16*)(ws + WS_S0), *S1 = (bf16*)(ws + WS_S1), *S2 = (bf16*)(ws + WS_S2), *S3 = (bf16*)(ws + WS_S3), *S4 = (bf16*)(ws + WS_S4), *S5 = (bf16*)(ws + WS_S5);
    float* rc = (float*)(ws + WS_ROPE); float* rs = (float*)(ws + WS_ROPE + 256 * 1024);
    for (int p = 0; p < NPHASE; ++p) {
        if (!((CFG_DUMB_MASK >> p) & 1)) { launch_mega(grid, a, p, p + 1, false, stream); continue; }
        DumbEpi e{};
        switch (p) {
        case 1: e.kind = 1; e.o0 = S1; e.o1 = S2; e.f0 = (const float*)(ws + WS_RINV0);
            hipLaunchKernelGGL(dumb_gemm, dim3(2048 / 64, M / 64), dim3(256), 0, stream, (const bf16*)S0, (const bf16*)(ws + WS_WIN), 2048, D, e); break;
        case 2: hipLaunchKernelGGL(dumb_ssm, dim3(256), dim3(64), 0, stream, (const bf16*)S1, S0, a.in[I_LRE], a.in[I_LIM], a.in[I_LOGDT], a.in[I_BRE], a.in[I_BIM], a.in[I_CRE], a.in[I_CIM], a.in[I_AD]); break;
        case 3: e.kind = 3; e.o0 = S1; e.i0 = S0; e.i1 = S2; e.f0 = a.in[I_GLUB];
            hipLaunchKernelGGL(dumb_gemm, dim3(1024 / 64, M / 64), dim3(256), 0, stream, (const bf16*)S0, (const bf16*)(ws + WS_WGLU), 1024, D, e); break;
        case 4: e.kind = 4; e.o0 = S0; e.f0 = a.in[I_X]; e.fo = a.out;
            hipLaunchKernelGGL(dumb_gemm, dim3(1024 / 64, M / 64), dim3(256), 0, stream, (const bf16*)S1, (const bf16*)(ws + WS_WOUT), 1024, D, e);
            hipLaunchKernelGGL(dumb_rowss, dim3(M / 4), dim3(256), 0, stream, (const float*)a.out, (float*)(ws + WS_PSS1)); break;
        case 5: e.kind = 5; e.o0 = S1; e.o1 = S2; e.o2 = S3; e.o3 = S4; e.f0 = (const float*)(ws + WS_PSS1);
            hipLaunchKernelGGL(dumb_gemm, dim3(4096 / 64, M / 64), dim3(256), 0, stream, (const bf16*)S0, (const bf16*)(ws + WS_WKVQ), 4096, D, e);
            hipLaunchKernelGGL(dumb_rope, dim3(M * 128 / 256), dim3(256), 0, stream, S1, (const float*)rc, (const float*)rs);
            hipLaunchKernelGGL(dumb_rope, dim3(M * 128 / 256), dim3(256), 0, stream, S3, (const float*)rc, (const float*)rs); break;
        case 6: hipLaunchKernelGGL(dumb_attn, dim3(T, 16, BATCH), dim3(128), 0, stream, (const bf16*)S3, (const bf16*)S1, (const bf16*)S2, S0, S5); break;
        case 8: e.kind = 4; e.o0 = nullptr; e.f0 = a.out; e.fo = a.out;
            hipLaunchKernelGGL(dumb_gemm, dim3(1024 / 64, M / 64), dim3(256), 0, stream, (const bf16*)S1, (const bf16*)(ws + WS_WBO), 1024, D, e);
            hipLaunchKernelGGL(dumb_rowss, dim3(M / 4), dim3(256), 0, stream, (const float*)a.out, (float*)(ws + WS_PSS2)); break;
        default: launch_mega(grid, a, p, p + 1, false, stream); break;
        }
    }
#endif
}
```

```cpp
#include <hip/hip_runtime.h>
#include <hip/hip_cooperative_groups.h>
#include <hip/hip_bf16.h>
#include <cstdio>
#include <cstdint>
#include <cmath>
namespace pg8 {
#define PG8_LAS __attribute__((address_space(3)))
typedef unsigned short bf16_t;
typedef short bf16x8 __attribute__((ext_vector_type(8)));
typedef float f32x4 __attribute__((ext_vector_type(4)));
typedef unsigned u32x4 __attribute__((ext_vector_type(4)));
constexpr int BM = 256, BK = 64, HALF = 128, HTB = HALF * BK * 2  , STAGE_BYTES = 8 * HTB, NXCD = 8, WGM = 8;

__host__ __device__ __forceinline__ int lds_byte(int r, int c) { const int st = (r >> 4) * 2 + (c >> 5), rr = r & 15, cc = c & 31, ob = rr * 64 + cc * 2; return st * 1024 + (ob ^ (((ob >> 9) & 1) << 5)); }
__host__ __device__ __forceinline__ void stage_rc(int b, int& R, int& C) { const int st = b / 1024, sb = b % 1024, swz = sb ^ (((sb >> 9) & 1) << 5); R = (st >> 1) * 16 + swz / 64; C = (st & 1) * 32 + (swz % 64) / 2; }
__host__ __device__ __forceinline__ int perm32(int rho) { const int n = rho >> 4, i = rho & 15; return 8 * (i >> 2) + 4 * n + (i & 3); }

struct Unit { int pm, pn; };
struct Gemm { const bf16_t* A; const bf16_t* Bt; int M, N, K; };

struct StaticOrder {
    int nM, nN, nwg, G, c;
    __host__ __device__ void init(int M, int N, int G_, int c_) { nM = M / BM; nN = N / BM; nwg = nM * nN; G = G_; c = c_; }
    __host__ __device__ bool next(int i, Unit& u) const {
        const long L = (long)i * G + c; if (L >= nwg) return false;
        int wgid = (int)L; { const int q = nwg / NXCD, r = nwg % NXCD, xcd = wgid % NXCD, off = wgid / NXCD; wgid = (xcd < r ? xcd * (q + 1) : r * (q + 1) + (xcd - r) * q) + off; }
        const int nig = WGM * nN, gid = wgid / nig, fm = gid * WGM, gsz = (nM - fm) < WGM ? (nM - fm) : WGM;
        u.pm = fm + ((wgid % nig) % gsz); u.pn = (wgid % nig) / gsz; return true;
    }
    __device__ __forceinline__ void a_ready(const Unit&) const {}
    __device__ __forceinline__ void done(const Unit&) const {}
};

__device__ __forceinline__ unsigned cvt_pk_bf16(float lo, float hi) { unsigned r; asm volatile("v_cvt_pk_bf16_f32 %0, %1, %2" : "=v"(r) : "v"(lo), "v"(hi)); return r; }
__device__ __forceinline__ int lane_id() { return (int)__builtin_amdgcn_mbcnt_hi(~0u, __builtin_amdgcn_mbcnt_lo(~0u, 0u)); }
__device__ __forceinline__ int lane_id_v() { int r; asm volatile("v_mbcnt_lo_u32_b32 %0, -1, 0\n\tv_mbcnt_hi_u32_b32 %0, -1, %0" : "=v"(r)); return r; }
__device__ __forceinline__ float bf_lo(unsigned w) { return __uint_as_float(w << 16); }
__device__ __forceinline__ float bf_hi(unsigned w) { return __uint_as_float(w & 0xffff0000u); }
__device__ __forceinline__ float sigm_f(float z) { return __builtin_amdgcn_rcpf(1.f + __builtin_amdgcn_exp2f(-1.4426950408889634f * z)); }
__device__ __forceinline__ float silu_f(float z) { return z * sigm_f(z); }
__device__ __forceinline__ u32x4 pack8(const f32x4 a, const f32x4 b) { u32x4 w; w.x = cvt_pk_bf16(a[0], a[1]); w.y = cvt_pk_bf16(a[2], a[3]); w.z = cvt_pk_bf16(b[0], b[1]); w.w = cvt_pk_bf16(b[2], b[3]); return w; }

struct EpiUZ {
    static constexpr bool PERM = true, AFTER_DRAIN = false;
    bf16_t* U; bf16_t* ZG; const float* rinv;
    __device__ __forceinline__ void operator()(const f32x4 (&acc)[2][2][4][2], const Unit& u, int wr, int wc, int fr, int fq) const {
        const bool isz = u.pn >= 4; bf16_t* base = isz ? ZG : U; const int colt = (isz ? u.pn - 4 : u.pn) * BM + wc * 32 + 8 * fq;
        float rv[2][4];
#pragma unroll
        for (int ai = 0; ai < 2; ++ai)
#pragma unroll
            for (int m = 0; m < 4; ++m) rv[ai][m] = rinv[u.pm * BM + ai * HALF + wr * 64 + m * 16 + fr];
#pragma unroll
        for (int ai = 0; ai < 2; ++ai)
#pragma unroll
            for (int m = 0; m < 4; ++m) { const int row = u.pm * BM + ai * HALF + wr * 64 + m * 16 + fr; const float ri = rv[ai][m];
                bf16_t* rowp = isz ? base + (size_t)row * 1024 + colt : base + ((size_t)((row >> 13) * 64 + (colt >> 4)) * 8192 + (row & 8191)) * 16 + (colt & 8);
                const size_t bjstep = isz ? (size_t)HALF : (size_t)(HALF / 16) * 8192 * 16;
#pragma unroll
                for (int bj = 0; bj < 2; ++bj) { f32x4 v0 = acc[ai][bj][m][0] * ri, v1 = acc[ai][bj][m][1] * ri;
                    if (isz) {
#pragma unroll
                        for (int k = 0; k < 4; ++k) { v0[k] = silu_f(v0[k]); v1[k] = silu_f(v1[k]); } }
                    *(u32x4*)(rowp + bj * bjstep) = pack8(v0, v1); } }
    }
};
struct EpiGlu {
    static constexpr bool PERM = true, AFTER_DRAIN = false;
    const bf16_t* YG; const bf16_t* ZG; const float* bias; bf16_t* Y2;
    __device__ __forceinline__ void operator()(const f32x4 (&acc)[2][2][4][2], const Unit& u, int wr, int wc, int fr, int fq) const {
        const int col0 = u.pn * BM + wc * 32 + 8 * fq;
        f32x4 bv[2][2];
#pragma unroll
        for (int bj = 0; bj < 2; ++bj)
#pragma unroll
            for (int n = 0; n < 2; ++n) bv[bj][n] = *(const f32x4*)(bias + col0 + bj * HALF + 4 * n);
#pragma unroll
        for (int ai = 0; ai < 2; ++ai) {
            u32x4 yw[4][2], zw[4][2];
#pragma unroll
            for (int m = 0; m < 4; ++m)
#pragma unroll
                for (int bj = 0; bj < 2; ++bj) { const size_t off = (size_t)(u.pm * BM + ai * HALF + wr * 64 + m * 16 + fr) * 1024 + col0 + bj * HALF; yw[m][bj] = *(const u32x4*)(YG + off); zw[m][bj] = *(const u32x4*)(ZG + off); }
#pragma unroll
            for (int m = 0; m < 4; ++m)
#pragma unroll
                for (int bj = 0; bj < 2; ++bj) { const size_t off = (size_t)(u.pm * BM + ai * HALF + wr * 64 + m * 16 + fr) * 1024 + col0 + bj * HALF;
                    const u32x4 y = yw[m][bj], z = zw[m][bj];
                    const f32x4 t0 = acc[ai][bj][m][0] + bv[bj][0], t1 = acc[ai][bj][m][1] + bv[bj][1];
                    f32x4 o0, o1;
                    o0[0] = bf_lo(y.x) * sigm_f(t0[0]) * bf_lo(z.x); o0[1] = bf_hi(y.x) * sigm_f(t0[1]) * bf_hi(z.x);
                    o0[2] = bf_lo(y.y) * sigm_f(t0[2]) * bf_lo(z.y); o0[3] = bf_hi(y.y) * sigm_f(t0[3]) * bf_hi(z.y);
                    o1[0] = bf_lo(y.z) * sigm_f(t1[0]) * bf_lo(z.z); o1[1] = bf_hi(y.z) * sigm_f(t1[1]) * bf_hi(z.z);
                    o1[2] = bf_lo(y.w) * sigm_f(t1[2]) * bf_lo(z.w); o1[3] = bf_hi(y.w) * sigm_f(t1[3]) * bf_hi(z.w);
                    *(u32x4*)(Y2 + off) = pack8(o0, o1); }
        }
    }
};
template <bool BASE_BF16> struct EpiRes {
    static constexpr bool PERM = true, AFTER_DRAIN = false;
    const void* X; bf16_t* HB; float* PSS;
    __device__ __forceinline__ void operator()(const f32x4 (&acc)[2][2][4][2], const Unit& u, int wr, int wc, int fr, int fq) const {
        const int col0 = u.pn * BM + wc * 32 + 8 * fq;
#pragma unroll
        for (int ai = 0; ai < 2; ++ai) {
            f32x4 b0[4][2], b1[4][2];
#pragma unroll
            for (int m = 0; m < 4; ++m)
#pragma unroll
                for (int bj = 0; bj < 2; ++bj) { const size_t off = (size_t)(u.pm * BM + ai * HALF + wr * 64 + m * 16 + fr) * 1024 + col0 + bj * HALF;
                    if (BASE_BF16) { const u32x4 w = *(const u32x4*)((const bf16_t*)X + off); b0[m][bj] = (f32x4){bf_lo(w.x), bf_hi(w.x), bf_lo(w.y), bf_hi(w.y)}; b1[m][bj] = (f32x4){bf_lo(w.z), bf_hi(w.z), bf_lo(w.w), bf_hi(w.w)}; }
                    else { b0[m][bj] = *(const f32x4*)((const float*)X + off); b1[m][bj] = *(const f32x4*)((const float*)X + off + 4); } }
#pragma unroll
            for (int m = 0; m < 4; ++m) { const int row = u.pm * BM + ai * HALF + wr * 64 + m * 16 + fr; float ss = 0.f;
#pragma unroll
                for (int bj = 0; bj < 2; ++bj) { const size_t off = (size_t)row * 1024 + col0 + bj * HALF;
                    const f32x4 h0 = b0[m][bj] + acc[ai][bj][m][0], h1 = b1[m][bj] + acc[ai][bj][m][1];
                    *(u32x4*)(HB + off) = pack8(h0, h1);
                    ss += (h0[0] * h0[0] + h0[1] * h0[1]) + (h0[2] * h0[2] + h0[3] * h0[3]) + (h1[0] * h1[0] + h1[1] * h1[1]) + (h1[2] * h1[2] + h1[3] * h1[3]); }
                ss += __shfl_xor(ss, 16); ss += __shfl_xor(ss, 32);
                if (fq == 0) PSS[(size_t)row * 16 + u.pn * 4 + wc] = ss; }
        }
    }
};
struct EpiKVQZ {
    static constexpr bool PERM = true, AFTER_DRAIN = false;
    bf16_t *K, *V, *Q, *ZG2; const float* PSS1; const float* ropec; const float* ropes; float qscale;
    __device__ __forceinline__ void operator()(const f32x4 (&acc)[2][2][4][2], const Unit& u, int wr, int wc, int fr, int fq) const {
        const int seg = u.pn >> 2; bf16_t* base = seg == 0 ? K : seg == 1 ? V : seg == 2 ? Q : ZG2; const int colt = (u.pn & 3) * BM + wc * 32 + 8 * fq;
        const bool roped = (seg == 0 || seg == 2) && ((wc & 1) == 0);
        const float sgn = fq == 0 ? -1.f : 1.f;
#pragma unroll
        for (int ai = 0; ai < 2; ++ai)
#pragma unroll
            for (int m = 0; m < 4; ++m) { const int row = u.pm * BM + ai * HALF + wr * 64 + m * 16 + fr;
                const f32x4* ps = (const f32x4*)(PSS1 + (size_t)row * 16); const f32x4 pa = ps[0], pb = ps[1], pc = ps[2], pd = ps[3];
                const float ssum = ((pa[0] + pa[1]) + (pa[2] + pa[3])) + ((pb[0] + pb[1]) + (pb[2] + pb[3])) + ((pc[0] + pc[1]) + (pc[2] + pc[3])) + ((pd[0] + pd[1]) + (pd[2] + pd[3]));
                float ri = 1.0f / sqrtf(ssum * (1.0f / 1024.0f) + 1e-6f); if (seg == 2) ri *= qscale;
                f32x4 c0, c1, s0, s1;
                if (roped) { const int pos = row & 8191; c0 = *(const f32x4*)(ropec + pos * 8); c1 = *(const f32x4*)(ropec + pos * 8 + 4); s0 = *(const f32x4*)(ropes + pos * 8); s1 = *(const f32x4*)(ropes + pos * 8 + 4); }
#pragma unroll
                for (int bj = 0; bj < 2; ++bj) { f32x4 v0 = acc[ai][bj][m][0] * ri, v1 = acc[ai][bj][m][1] * ri;
                    if (roped) { f32x4 p0, p1;
#pragma unroll
                        for (int k = 0; k < 4; ++k) { p0[k] = __int_as_float(__builtin_amdgcn_ds_swizzle(__float_as_int(v0[k]), 0x401F)); p1[k] = __int_as_float(__builtin_amdgcn_ds_swizzle(__float_as_int(v1[k]), 0x401F)); }
                        if (fq < 2) {
#pragma unroll
                            for (int k = 0; k < 4; ++k) { v0[k] = v0[k] * c0[k] + sgn * p0[k] * s0[k]; v1[k] = v1[k] * c1[k] + sgn * p1[k] * s1[k]; } } }
                    if (seg == 3) {
#pragma unroll
                        for (int k = 0; k < 4; ++k) { v0[k] = silu_f(v0[k]); v1[k] = silu_f(v1[k]); } }
                    *(u32x4*)(base + (size_t)row * 1024 + colt + bj * HALF) = pack8(v0, v1); } }
    }
};
template <class Epi, class Sched, bool ALIGN_EPI = false, bool SP2 = false>
__device__ __forceinline__ void gemm_phase(const int wv, PG8_LAS unsigned char* lds, const Gemm g, const Sched& S, const Epi& E) {
    const int lane = lane_id(), wid = wv, tid = wv * 64 + lane, wr = wid >> 2, wc = wid & 3, fr = lane & 15, fq = lane >> 4;
    const int K = g.K, nt = K / BK;
    unsigned voffA[2], voffB[2];
#pragma unroll
    for (int i = 0; i < 2; ++i) { int R, C; stage_rc(tid * 16 + i * 8192, R, C); const int Rb = Epi::PERM ? ((R & ~31) + perm32(R & 31)) : R;
        voffA[i] = (unsigned)(R * K + C) * 2u; voffB[i] = (unsigned)(Rb * K + C) * 2u; }
    const size_t kstep = (size_t)(BK * 2);
    const size_t hstep = (size_t)HALF * K * 2;
    const size_t tstep = 2 * hstep;
    const unsigned ldsw = (unsigned)wid * 1024u;
    const int aoff = lds_byte(wr * 64 + fr, fq * 8), boff = lds_byte(wc * 32 + fr, fq * 8);
#define PG8_SA(b, h) (((b) * 2 + (h)) * HTB)
#define PG8_SB(b, h) ((4 + (b) * 2 + (h)) * HTB)
#define PG8_STAGE(bufoff, gbase, voff) do { _Pragma("unroll") for (int _i = 0; _i < 2; ++_i) \
        __builtin_amdgcn_global_load_lds((const unsigned*)((const char*)(gbase) + (voff)[_i]), (PG8_LAS unsigned*)(lds + (bufoff) + ldsw + _i * 8192), 16, 0, 0); } while (0)
#define PG8_LDA(dst, b, h) do { _Pragma("unroll") for (int m = 0; m < 4; ++m) _Pragma("unroll") for (int k = 0; k < 2; ++k) dst[m][k] = *(const PG8_LAS bf16x8*)(lds + PG8_SA(b, h) + aoff + m * 2048 + k * 1024); } while (0)
#define PG8_LDB(dst, b, h) do { _Pragma("unroll") for (int n = 0; n < 2; ++n) _Pragma("unroll") for (int k = 0; k < 2; ++k) dst[n][k] = *(const PG8_LAS bf16x8*)(lds + PG8_SB(b, h) + boff + n * 2048 + k * 1024); } while (0)
#define PG8_MMA(ai, bj, At, Bt) do { __builtin_amdgcn_s_setprio(1); _Pragma("unroll") for (int m = 0; m < 4; ++m) _Pragma("unroll") for (int n = 0; n < 2; ++n) _Pragma("unroll") for (int k = 0; k < 2; ++k) \
        acc[ai][bj][m][n] = __builtin_amdgcn_mfma_f32_16x16x32_bf16(Bt[n][k], At[m][k], acc[ai][bj][m][n], 0, 0, 0); __builtin_amdgcn_s_setprio(0); } while (0)
#define PG8_WAIT_V(n) asm volatile("s_waitcnt vmcnt(" #n ")" ::: "memory")
#define PG8_WAIT_L(n) asm volatile("s_waitcnt lgkmcnt(" #n ")" ::: "memory")
#define PG8_BAR __builtin_amdgcn_s_barrier()
#define PG8_SCHED __builtin_amdgcn_sched_barrier(0)
    Unit cur, nxt; int ui = 0;
    if (!S.next(0, cur)) return;
    f32x4 acc[2][2][4][2];
#pragma unroll
    for (int a = 0; a < 2; ++a)
#pragma unroll
        for (int b = 0; b < 2; ++b)
#pragma unroll
            for (int m = 0; m < 4; ++m)
#pragma unroll
                for (int n = 0; n < 2; ++n) acc[a][b][m][n] = (f32x4){0.f, 0.f, 0.f, 0.f};
    bf16x8 At[4][2], B0[2][2], B1[2][2];
    const char* cA = (const char*)g.A + (size_t)cur.pm * tstep; const char* cB = (const char*)g.Bt + (size_t)cur.pn * tstep;
    S.a_ready(cur);
    if constexpr (SP2) {
        PG8_STAGE(PG8_SB(0, 0), cB, voffB); PG8_STAGE(PG8_SB(0, 1), cB + hstep, voffB); PG8_STAGE(PG8_SA(0, 0), cA, voffA); PG8_STAGE(PG8_SA(0, 1), cA + hstep, voffA);
        if (wr == 1) PG8_BAR;
        PG8_WAIT_V(2); PG8_BAR;
        PG8_STAGE(PG8_SB(1, 0), cB + kstep, voffB); PG8_STAGE(PG8_SA(1, 0), cA + kstep, voffA); PG8_STAGE(PG8_SB(1, 1), cB + hstep + kstep, voffB);
        PG8_WAIT_V(6); PG8_BAR;
    } else {
        PG8_STAGE(PG8_SB(0, 0), cB, voffB); PG8_STAGE(PG8_SA(0, 0), cA, voffA); PG8_STAGE(PG8_SB(0, 1), cB + hstep, voffB); PG8_STAGE(PG8_SA(0, 1), cA + hstep, voffA);
        if (wr == 1) PG8_BAR;
        PG8_WAIT_V(4); PG8_BAR;
        PG8_STAGE(PG8_SB(1, 0), cB + kstep, voffB); PG8_STAGE(PG8_SA(1, 0), cA + kstep, voffA); PG8_STAGE(PG8_SB(1, 1), cB + hstep + kstep, voffB);
        PG8_WAIT_V(6); PG8_BAR;
    }
    for (;;) {
        const bool has_next = S.next(ui + 1, nxt);
        const char* nA = has_next ? (const char*)g.A + (size_t)nxt.pm * tstep : cA; const char* nB = has_next ? (const char*)g.Bt + (size_t)nxt.pn * tstep : cB;
        for (int t = 0; t < nt; t += 2) {
            const bool last = (t == nt - 2);
            const char* a1 = cA + (size_t)(t + 1) * kstep;
            const char* a2 = last ? nA : cA + (size_t)(t + 2) * kstep; const char* b2 = last ? nB : cB + (size_t)(t + 2) * kstep;
            const char* a3 = a2 + kstep; const char* b3 = b2 + kstep;
            if (last && has_next) S.a_ready(nxt);
            if constexpr (SP2) {
            PG8_LDB(B0, 0, 0); PG8_LDB(B1, 0, 1); PG8_SCHED; PG8_LDA(At, 0, 0); PG8_STAGE(PG8_SA(1, 1), a1 + hstep, voffA);
            PG8_WAIT_V(8); PG8_WAIT_L(0); PG8_BAR; PG8_MMA(0, 0, At, B0); PG8_MMA(0, 1, At, B1); PG8_BAR; PG8_SCHED;
            PG8_LDA(At, 0, 1); PG8_STAGE(PG8_SB(0, 0), b2, voffB); PG8_STAGE(PG8_SB(0, 1), b2 + hstep, voffB); PG8_STAGE(PG8_SA(0, 0), a2, voffA);
            PG8_WAIT_V(8); PG8_WAIT_L(0); PG8_BAR; PG8_MMA(1, 0, At, B0); PG8_MMA(1, 1, At, B1); PG8_BAR; PG8_SCHED;
            PG8_LDB(B0, 1, 0); PG8_LDB(B1, 1, 1); PG8_SCHED; PG8_LDA(At, 1, 0); PG8_STAGE(PG8_SA(0, 1), a2 + hstep, voffA);
            PG8_WAIT_V(8); PG8_WAIT_L(0); PG8_BAR; PG8_MMA(0, 0, At, B0); PG8_MMA(0, 1, At, B1); PG8_BAR; PG8_SCHED;
            PG8_LDA(At, 1, 1); PG8_STAGE(PG8_SB(1, 0), b3, voffB); PG8_STAGE(PG8_SB(1, 1), b3 + hstep, voffB); PG8_STAGE(PG8_SA(1, 0), a3, voffA);
            PG8_WAIT_V(8); PG8_WAIT_L(0); PG8_BAR; PG8_MMA(1, 0, At, B0); PG8_MMA(1, 1, At, B1); PG8_BAR; PG8_SCHED;
            } else {
            PG8_LDB(B0, 0, 0); PG8_SCHED; PG8_LDA(At, 0, 0); PG8_STAGE(PG8_SA(1, 1), a1 + hstep, voffA);
            PG8_WAIT_L(8); PG8_BAR; PG8_WAIT_L(0); PG8_MMA(0, 0, At, B0); PG8_BAR; PG8_SCHED;
            PG8_LDB(B1, 0, 1); PG8_STAGE(PG8_SB(0, 0), b2, voffB);
            PG8_BAR; PG8_WAIT_L(0); PG8_MMA(0, 1, At, B1); PG8_BAR;
            PG8_LDA(At, 0, 1); PG8_STAGE(PG8_SA(0, 0), a2, voffA);
            PG8_BAR; PG8_WAIT_L(0); PG8_MMA(1, 0, At, B0); PG8_BAR; PG8_SCHED;
            PG8_STAGE(PG8_SB(0, 1), b2 + hstep, voffB);
            PG8_WAIT_V(6); PG8_BAR; PG8_MMA(1, 1, At, B1); PG8_BAR;
            PG8_LDB(B0, 1, 0); PG8_SCHED; PG8_LDA(At, 1, 0); PG8_STAGE(PG8_SA(0, 1), a2 + hstep, voffA);
            PG8_WAIT_L(8); PG8_BAR; PG8_WAIT_L(0); PG8_MMA(0, 0, At, B0); PG8_BAR; PG8_SCHED;
            PG8_LDB(B1, 1, 1); PG8_STAGE(PG8_SB(1, 0), b3, voffB);
            PG8_BAR; PG8_WAIT_L(0); PG8_MMA(0, 1, At, B1); PG8_BAR;
            PG8_LDA(At, 1, 1); PG8_STAGE(PG8_SA(1, 0), a3, voffA);
            PG8_BAR; PG8_WAIT_L(0); PG8_MMA(1, 0, At, B0); PG8_BAR; PG8_SCHED;
            PG8_STAGE(PG8_SB(1, 1), b3 + hstep, voffB);
            PG8_WAIT_V(6); PG8_BAR; PG8_MMA(1, 1, At, B1); PG8_BAR;
            }
        }
        if constexpr (ALIGN_EPI) { if (wr == 0) PG8_BAR; }
        if constexpr (!Epi::AFTER_DRAIN) { E(acc, cur, wr, wc, fr, fq); S.done(cur); }
        if (!has_next) break;
#pragma unroll
        for (int a = 0; a < 2; ++a)
#pragma unroll
            for (int b = 0; b < 2; ++b)
#pragma unroll
                for (int m = 0; m < 4; ++m)
#pragma unroll
                    for (int n = 0; n < 2; ++n) acc[a][b][m][n] = (f32x4){0.f, 0.f, 0.f, 0.f};
        cur = nxt; cA = nA; cB = nB; ++ui;
        if constexpr (ALIGN_EPI) { if (wr == 1) PG8_BAR; }
    }
    PG8_WAIT_V(0);
    if constexpr (!ALIGN_EPI) { if (wr == 0) PG8_BAR; }
    PG8_BAR;
    if constexpr (Epi::AFTER_DRAIN) { E.fused(acc, cur, wr, wc, fr, fq, lds, wid, lane); S.done(cur); }
#undef PG8_SA
#undef PG8_SB
#undef PG8_STAGE
#undef PG8_LDA
#undef PG8_LDB
#undef PG8_MMA
#undef PG8_WAIT_V
#undef PG8_WAIT_L
#undef PG8_BAR
#undef PG8_SCHED
}
}
#define PG8_SP2 true
#define PG8_ALIGN true
namespace attn_body {
using bf16=__hip_bfloat16;
using bf16x8=__attribute__((ext_vector_type(8)))short;
using s16x4=__attribute__((ext_vector_type(4)))short;
using f32x16=__attribute__((ext_vector_type(16)))float;
using u32x4=__attribute__((ext_vector_type(4)))unsigned;
constexpr int BATCH=4,NHEAD=16,SEQ=8192,D=64,DM=NHEAD*D;
constexpr int NW=8,QBLK=32,QB=QBLK*NW,KVBLK=64,NQB=SEQ/QB;
constexpr int ATTN_PITCH=DM, ATTN_UNIT_ROWS=QB;
__device__ __forceinline__ int crow(int r,int hi){return (r&3)+8*(r>>2)+4*hi;}
#define SBAR() __builtin_amdgcn_sched_barrier(0)
__device__ __forceinline__ void cmask(f32x16&p0,f32x16&p1,int jb,int qrel,int hi){
  const float NEG=-INFINITY; int kb=64*jb+4*hi;
  #pragma unroll
  for(int r=0;r<16;++r){int kv=kb+(r&3)+8*(r>>2); if(kv>qrel)p0[r]=NEG; if(kv+32>qrel)p1[r]=NEG;}
}

constexpr int NSLOT=3, SLOTB=8192;
constexpr int LDS_K=0, LDS_V=NSLOT*SLOTB, LDS_WS=3*NSLOT*SLOTB, LDS_OST=LDS_WS+NW*64*4, LDS_BYTES=LDS_OST+NW*8192;
constexpr float C2=0.125f*1.4426950408889634f;
__device__ __forceinline__ void glds16(const void*gsrc,unsigned lds_dst){unsigned keep;
  asm volatile("s_mov_b32 %0, m0\n\ts_mov_b32 m0, %2\n\ts_nop 0\n\tglobal_load_lds_dwordx4 %1, off\n\ts_mov_b32 m0, %0":"=&s"(keep):"v"(gsrc),"s"(lds_dst):"memory");}
__device__ __forceinline__ int lane_opaque(){int r;asm volatile("v_mbcnt_lo_u32_b32 %0, -1, 0\n\tv_mbcnt_hi_u32_b32 %0, -1, %0":"=v"(r));return r;}
__device__ __forceinline__ float max3f(float a,float b,float c){float r;asm("v_max3_f32 %0, %1, %2, %3":"=v"(r):"v"(a),"v"(b),"v"(c));return r;}
__device__ __forceinline__ float max2f(float a,float b){float r;asm("v_max_f32_e32 %0, %1, %2":"=v"(r):"v"(a),"v"(b));return r;}
__device__ __forceinline__ float fadd_s(float a,float b){float r;asm("v_add_f32_e32 %0, %1, %2":"=v"(r):"v"(a),"v"(b));return r;}
__device__ __forceinline__ float fsub_s(float a,float b){float r;asm("v_sub_f32_e32 %0, %1, %2":"=v"(r):"v"(a),"v"(b));return r;}
typedef float f32x2_t __attribute__((ext_vector_type(2))); typedef __bf16 bf16x2_t __attribute__((ext_vector_type(2)));
__device__ __forceinline__ unsigned cvtpk_s(float lo,float hi){f32x2_t v={lo,hi};bf16x2_t b=__builtin_convertvector(v,bf16x2_t);return __builtin_bit_cast(unsigned,b);}
#define WAIT_BAR(N) asm volatile("s_waitcnt vmcnt(" #N ") lgkmcnt(0)\n\ts_barrier":::"memory")

__device__ __forceinline__ void qkt(f32x16&p0,f32x16&p1,const char*Kslot,const bf16x8*qr,int r32,int hi){
  const char*kb=Kslot+hi*1024+r32*16;
  #pragma unroll
  for(int d0=0;d0<4;++d0){
    const bf16x8 b0=*reinterpret_cast<const bf16x8*>(kb+d0*2048);
    const bf16x8 b1=*reinterpret_cast<const bf16x8*>(kb+d0*2048+512);
    if(d0==0){p0=__builtin_amdgcn_mfma_f32_32x32x16_bf16(b0,qr[0],f32x16{},0,0,0);p1=__builtin_amdgcn_mfma_f32_32x32x16_bf16(b1,qr[0],f32x16{},0,0,0);}
    else{p0=__builtin_amdgcn_mfma_f32_32x32x16_bf16(b0,qr[d0],p0,0,0,0);p1=__builtin_amdgcn_mfma_f32_32x32x16_bf16(b1,qr[d0],p1,0,0,0);}}
}
typedef __attribute__((address_space(3))) const char* lds_cptr;
typedef short v4i16_t __attribute__((ext_vector_type(4)));
__device__ __forceinline__ void kload8(bf16x8*kf,lds_cptr kp){
  kf[0]=*(const __attribute__((address_space(3))) bf16x8*)(kp);      kf[1]=*(const __attribute__((address_space(3))) bf16x8*)(kp+512);
  kf[2]=*(const __attribute__((address_space(3))) bf16x8*)(kp+2048); kf[3]=*(const __attribute__((address_space(3))) bf16x8*)(kp+2560);
  kf[4]=*(const __attribute__((address_space(3))) bf16x8*)(kp+4096); kf[5]=*(const __attribute__((address_space(3))) bf16x8*)(kp+4608);
  kf[6]=*(const __attribute__((address_space(3))) bf16x8*)(kp+6144); kf[7]=*(const __attribute__((address_space(3))) bf16x8*)(kp+6656);
}
__device__ __forceinline__ void kload2(bf16x8*kf,lds_cptr kp,int j){ kf[2*j]=*(const __attribute__((address_space(3))) bf16x8*)(kp+j*2048); kf[2*j+1]=*(const __attribute__((address_space(3))) bf16x8*)(kp+j*2048+512); }
__device__ __forceinline__ s16x4 vtr(lds_cptr p){ return __builtin_bit_cast(s16x4,__builtin_amdgcn_ds_read_tr16_b64_v4i16((__attribute__((address_space(3))) v4i16_t*)p)); }
__device__ __forceinline__ float rowmax(const f32x16&p0,const f32x16&p1){
  float a=max3f(p0[0],p0[1],p1[0]),b=max3f(p0[2],p0[3],p1[1]);a=max3f(a,p1[2],p1[3]);
  #pragma unroll
  for(int r=4;r<16;r+=4){a=max3f(a,p0[r],p0[r+1]);b=max3f(b,p0[r+2],p0[r+3]);a=max3f(a,p1[r],p1[r+1]);b=max3f(b,p1[r+2],p1[r+3]);}
  const float m=max2f(a,b);
  auto rr=__builtin_amdgcn_permlane32_swap(__float_as_uint(m),__float_as_uint(m),false,false);
  return max2f(__uint_as_float(rr[0]),__uint_as_float(rr[1]));
}
__device__ __forceinline__ void pv(f32x16*o,int vb,bf16x8 pa0,bf16x8 pa1,bf16x8 pa2,bf16x8 pa3){
  #pragma unroll
  for(int d0=0;d0<4;++d0){s16x4 lo[4],hi[4];
    #pragma unroll
    for(int ks=0;ks<4;++ks){
      asm volatile("ds_read_b64_tr_b16 %0,%1 offset:%c2":"=&v"(lo[ks]):"v"(vb),"i"((d0>>1)*8192+(d0&1)*4096+ks*1024):"memory");
      asm volatile("ds_read_b64_tr_b16 %0,%1 offset:%c2":"=&v"(hi[ks]):"v"(vb),"i"((d0>>1)*8192+(d0&1)*4096+ks*1024+512):"memory");}
    asm volatile("s_waitcnt lgkmcnt(0)":::"memory");SBAR();
    #define PK(k) (bf16x8){lo[k][0],lo[k][1],lo[k][2],lo[k][3],hi[k][0],hi[k][1],hi[k][2],hi[k][3]}
    o[d0]=__builtin_amdgcn_mfma_f32_32x32x16_bf16(pa0,PK(0),o[d0],0,0,0);
    o[d0]=__builtin_amdgcn_mfma_f32_32x32x16_bf16(pa1,PK(1),o[d0],0,0,0);
    o[d0]=__builtin_amdgcn_mfma_f32_32x32x16_bf16(pa2,PK(2),o[d0],0,0,0);
    o[d0]=__builtin_amdgcn_mfma_f32_32x32x16_bf16(pa3,PK(3),o[d0],0,0,0);
    #undef PK
  }
}

#ifndef ATTN_STORE16
#define ATTN_STORE16(p,v) (*(u32x4*)(p)=(v))
#endif
struct Comb { const bf16* ZG; bf16* A2; const float* subg; float lam, oml; };
template<int THRL> __device__ __forceinline__ void attn_unit(const int MODE,const int wv,int b,int h,int vcol,int qb,const bf16*Q,const bf16*__restrict__ K,const bf16*__restrict__ V,bf16*O,char*shm,const Comb&ca){
  const int lane=pg8::lane_id(),r32=lane&31,hi=lane>>5; const int wid=wv;
  const long rowbase=(long)b*SEQ; const int q0=qb*QB;
  const bf16*Qw=Q+(rowbase+q0+wid*QBLK)*DM+h*D;
  const bf16*Kh=K+rowbase*DM+h*D,*Vh=V+rowbase*DM+vcol;
  const unsigned lds0=(unsigned)(uintptr_t)shm;
  float*wsf=(float*)(shm+LDS_WS)+wid*64;
  const bf16*ksrc=Kh+(long)lane*DM+wid*8;
  const bf16*vsrc=Vh+(long)(16*(wid&3)+(lane>>2))*DM+(wid>>2)*32+(lane&3)*8;
  const unsigned kdst=lds0+LDS_K+wid*1024, vdst=lds0+LDS_V+wid*1024;
  #define DMA_K(t,slot) glds16(ksrc+(long)(t)*KVBLK*DM,(unsigned)__builtin_amdgcn_readfirstlane(kdst+(slot)))
  #define DMA_V(t,slot) do{ glds16(vsrc+(long)(t)*KVBLK*DM,(unsigned)__builtin_amdgcn_readfirstlane(vdst+2*(slot))); glds16(vsrc+64+(long)(t)*KVBLK*DM,(unsigned)__builtin_amdgcn_readfirstlane(vdst+2*(slot)+8192)); }while(0)
  const char*Kbase=shm+LDS_K; bf16x8 kf[8];
  const lds_cptr shm3=(lds_cptr)shm; const lds_cptr kp0=shm3+LDS_K+hi*1024+r32*16; const lds_cptr vp0=shm3+LDS_V+((lane>>4)&1)*32+(lane&3)*8+(4*hi+((lane&15)>>2))*64;
  const int NT=(q0+QB)/KVBLK;
  DMA_K(0,0);DMA_V(0,0);DMA_K(1,SLOTB);
  bf16x8 qr[4];
  #pragma unroll
  for(int d0=0;d0<4;++d0)qr[d0]=*reinterpret_cast<const bf16x8*>(&Qw[(long)r32*DM+d0*16+hi*8]);
  const lds_cptr qp_=shm3+LDS_OST+wid*8192+lane*16;
  #define QLD(d) (*(const __attribute__((address_space(3))) bf16x8*)(qp_+(d)*1024))
  float mhat=0.f,l_reg=0.f;f32x16 o[4];o[0]=f32x16{};o[1]=f32x16{};o[2]=f32x16{};o[3]=f32x16{};
  const int qrel=wid*QBLK+r32;
  #define CMASK(P0,P1,t) do{int jb_=(t)-(NT-4); if(jb_>=0)cmask(P0,P1,jb_,qrel,hi);}while(0)
  bool resc=false;
  #define START(P0,P1) do{ const float rm=rowmax(P0,P1); resc=false; \
    { const float dl=rm; mhat=fadd_s(mhat,dl); \
      _Pragma("unroll") for(int r=0;r<16;++r){P0[r]=fsub_s(P0[r],dl);P1[r]=fsub_s(P1[r],dl);} \
      } \
    _Pragma("unroll") for(int r=0;r<16;++r)P0[r]=__builtin_amdgcn_exp2f(P0[r]); }while(0)
  #define RESC() do{ if(resc){ asm volatile("s_waitcnt lgkmcnt(0)":::"memory"); \
      _Pragma("unroll") for(int d_=0;d_<4;++d_) _Pragma("unroll") for(int r=0;r<16;++r)o[d_][r]*=wsf[crow(r,hi)]; } }while(0)
  f32x16 pA0,pA1,pB0,pB1;
  int sl_prev=0,sl_cur=0,sl_next=SLOTB;
  #define ROT() do{sl_prev=sl_cur;sl_cur=sl_next;sl_next=(sl_next==(NSLOT-1)*SLOTB)?0:sl_next+SLOTB;}while(0)
  DMA_K(2,2*SLOTB);
  _Pragma("unroll") for(int d0=0;d0<4;++d0)*(__attribute__((address_space(3))) bf16x8*)(qp_+d0*1024)=qr[d0];
  WAIT_BAR(3);
  qkt(pA0,pA1,Kbase,qr,r32,hi);asm volatile("s_nop 15\n\ts_nop 7":"+v"(pA0),"+v"(pA1));CMASK(pA0,pA1,0);
  START(pA0,pA1);
  _Pragma("unroll") for(int r=0;r<16;++r)pA1[r]=__builtin_amdgcn_exp2f(pA1[r]);
  WAIT_BAR(0);
  DMA_K(3,0);DMA_V(1,SLOTB);
  ROT();
  kload8(kf,kp0+sl_cur);
  WAIT_BAR(3);
  s16x4 vlo[4],vhi[4]; u32x4 pw0,pw1,pw2,pw3;
  #define PKW(P,B) cvtpk_s(P[B],P[B+1])
  #define PAF(k) __builtin_bit_cast(bf16x8,pw##k)
  #define PIN(x) asm volatile("":"+v"(x))
  #define MX3(a,b,c) __builtin_fmaxf(__builtin_fmaxf((a),(b)),(c))
  #define GAPA(MF,A0,A1,A2,A3,W0,W1,PW) do{ MF; sacc+=A0; sacc+=A1; sacc+=A2; sacc+=A3; PIN(sacc); W0; W1; PIN(PW); SBAR(); }while(0)
  #define EX(v) __builtin_amdgcn_exp2f(v)
  #define GAPB(MF,X,B) do{ MF; X[B]=EX(X[B]-mhat); X[B+1]=EX(X[B+1]-mhat); PIN(X); SBAR(); }while(0)
  #define VRN(f) do{ vlo[(f)&3]=vtr(vp_+((((f)&3)>>1)*8192+((f)&1)*4096+((f)>>2)*1024)); vhi[(f)&3]=vtr(vp_+((((f)&3)>>1)*8192+((f)&1)*4096+((f)>>2)*1024+512)); }while(0)
  #define VFQ(i) (bf16x8){vlo[i][0],vlo[i][1],vlo[i][2],vlo[i][3],vhi[i][0],vhi[i][1],vhi[i][2],vhi[i][3]}
  #define MFB(k,d) o[d]=__builtin_amdgcn_mfma_f32_32x32x16_bf16(PAF(k),VFQ(d),o[d],0,0,0)
  #define KRD(G,j) do{ if(G){ kload2(kf,kp0+sl_next,j); SBAR(); } }while(0)
  #define STEP(C0,C1,P0,P1,t,GK,GV,GL) do{ SBAR(); \
    const lds_cptr vp_=vp0+2*sl_prev; \
    bf16x8 qa_=QLD(0), qb_=QLD(1); float sacc=(P0[0]+P0[1]); \
    GAPA(C0=__builtin_amdgcn_mfma_f32_32x32x16_bf16(kf[0],qa_,f32x16{},0,0,0), P0[2],P0[3],P0[4],P0[5],     pw0[0]=PKW(P0,0), pw0[1]=PKW(P0,2), pw0); \
    GAPA(C1=__builtin_amdgcn_mfma_f32_32x32x16_bf16(kf[1],qa_,f32x16{},0,0,0), P0[6],P0[7],P0[8],P0[9],     pw0[2]=PKW(P0,4), pw0[3]=PKW(P0,6), pw0); \
    qa_=QLD(2); \
    GAPA(C0=__builtin_amdgcn_mfma_f32_32x32x16_bf16(kf[2],qb_,C0,0,0,0),   P0[10],P0[11],P0[12],P0[13], pw1[0]=PKW(P0,8), pw1[1]=PKW(P0,10), pw1); \
    GAPA(C1=__builtin_amdgcn_mfma_f32_32x32x16_bf16(kf[3],qb_,C1,0,0,0),   P0[14],P0[15],P1[0],P1[1],   pw1[2]=PKW(P0,12),pw1[3]=PKW(P0,14), pw1); \
    qb_=QLD(3); \
    GAPA(C0=__builtin_amdgcn_mfma_f32_32x32x16_bf16(kf[4],qa_,C0,0,0,0),   P1[2],P1[3],P1[4],P1[5],     pw2[0]=PKW(P1,0), pw2[1]=PKW(P1,2), pw2); \
    GAPA(C1=__builtin_amdgcn_mfma_f32_32x32x16_bf16(kf[5],qa_,C1,0,0,0),   P1[6],P1[7],P1[8],P1[9],     pw2[2]=PKW(P1,4), pw2[3]=PKW(P1,6), pw2); \
    GAPA(C0=__builtin_amdgcn_mfma_f32_32x32x16_bf16(kf[6],qb_,C0,0,0,0),   P1[10],P1[11],P1[12],P1[13], pw3[0]=PKW(P1,8), pw3[1]=PKW(P1,10), pw3); \
    GAPA(C1=__builtin_amdgcn_mfma_f32_32x32x16_bf16(kf[7],qb_,C1,0,0,0),   P1[14],P1[15],0.f,0.f,       pw3[2]=PKW(P1,12),pw3[3]=PKW(P1,14), pw3); \
    l_reg+=sacc; \
    if(GK){DMA_K((t)+3,sl_cur);} if(GV){DMA_V((t)+1,sl_next);} \
    VRN(0); VRN(1); VRN(2); \
    CMASK(C0,C1,t); \
    { float a=MX3(C0[0],C0[1],C1[0]),b=MX3(C0[2],C0[3],C1[1]); a=MX3(a,C1[2],C1[3]); \
      _Pragma("unroll") for(int r=4;r<16;r+=4){a=MX3(a,C0[r],C0[r+1]);b=MX3(b,C0[r+2],C0[r+3]);a=MX3(a,C1[r],C1[r+1]);b=MX3(b,C1[r+2],C1[r+3]);} \
      float rm=__builtin_fmaxf(a,b); { auto rr=__builtin_amdgcn_permlane32_swap(__float_as_uint(rm),__float_as_uint(rm),false,false); rm=__builtin_fmaxf(__uint_as_float(rr[0]),__uint_as_float(rr[1]))-mhat; } \
      resc=false; \
      if(__builtin_expect(__any(rm>(float)THRL),0)){ const float dl=__builtin_fmaxf(rm,0.f); mhat+=dl; \
        const float f=__builtin_amdgcn_exp2f(-dl); l_reg*=f; if(hi==0)wsf[lane_opaque()&31]=f; resc=true; } } \
    SBAR(); \
    VRN(3);  GAPB(MFB(0,0), C0,0); \
    VRN(4);  GAPB(MFB(0,1), C0,2); \
    VRN(5);  GAPB(MFB(0,2), C0,4); \
    VRN(6);  GAPB(MFB(0,3), C0,6); \
    KRD(GL,0); VRN(7);  GAPB(MFB(1,0), C0,8); \
    VRN(8);  GAPB(MFB(1,1), C0,10); \
    KRD(GL,1); VRN(9);  GAPB(MFB(1,2), C0,12); \
    VRN(10); GAPB(MFB(1,3), C0,14); \
    KRD(GL,2); VRN(11); GAPB(MFB(2,0), C1,0); \
    VRN(12); GAPB(MFB(2,1), C1,2); \
    KRD(GL,3); VRN(13); GAPB(MFB(2,2), C1,4); \
    VRN(14); GAPB(MFB(2,3), C1,6); \
    VRN(15); GAPB(MFB(3,0), C1,8); \
    GAPB(MFB(3,1), C1,10); \
    GAPB(MFB(3,2), C1,12); \
    GAPB(MFB(3,3), C1,14); \
    }while(0)
  int t=1;
  #undef CMASK
  #define CMASK(P0,P1,t) do{}while(0)
  for(;t+5<NT;t+=2){
    STEP(pB0,pB1,pA0,pA1,t,true,true,true);     WAIT_BAR(3); RESC(); ROT();
    STEP(pA0,pA1,pB0,pB1,t+1,true,true,true);   WAIT_BAR(3); RESC(); ROT();
  }
  #undef CMASK
  #define CMASK(P0,P1,t) do{int jb_=(t)-(NT-4); if(jb_>=0)cmask(P0,P1,jb_,qrel,hi);}while(0)
  #define ENDW(tt) do{ if((tt)+3<NT){WAIT_BAR(3);} else if((tt)+2<NT){WAIT_BAR(2);} else {WAIT_BAR(0);} }while(0)
  for(;t+1<NT;t+=2){
    STEP(pB0,pB1,pA0,pA1,t,(t+3<NT),(t+1<NT),(t+1<NT));       ENDW(t);   RESC(); ROT();
    STEP(pA0,pA1,pB0,pB1,t+1,(t+4<NT),(t+2<NT),(t+2<NT));     ENDW(t+1); RESC(); ROT();
  }
  STEP(pB0,pB1,pA0,pA1,NT-1,false,false,false); RESC();
  { float sacc=pB0[0]+pB0[1]; _Pragma("unroll") for(int r=2;r<16;++r)sacc+=pB0[r]; _Pragma("unroll") for(int r=0;r<16;++r)sacc+=pB1[r]; l_reg+=sacc;
    pw0=(u32x4){PKW(pB0,0),PKW(pB0,2),PKW(pB0,4),PKW(pB0,6)};pw1=(u32x4){PKW(pB0,8),PKW(pB0,10),PKW(pB0,12),PKW(pB0,14)};pw2=(u32x4){PKW(pB1,0),PKW(pB1,2),PKW(pB1,4),PKW(pB1,6)};pw3=(u32x4){PKW(pB1,8),PKW(pB1,10),PKW(pB1,12),PKW(pB1,14)};
    SBAR(); const int vb0=(int)(lds0+LDS_V)+((lane>>4)&1)*32+(lane&3)*8+(4*hi+((lane&15)>>2))*64; pv(o,vb0+2*sl_cur,PAF(0),PAF(1),PAF(2),PAF(3)); }
  #undef PKW
  #undef PAF
  #undef VFQ
  #undef MFB
  #undef PIN
  #undef MX3
  #undef GAPA
  #undef GAPB
  #undef EX
  #undef VRN
  #undef KRD
  #undef STEP
  #undef ENDW
  {auto rr=__builtin_amdgcn_permlane32_swap(__float_as_uint(l_reg),__float_as_uint(l_reg),false,false);l_reg=__uint_as_float(rr[0])+__uint_as_float(rr[1]);}
  if(hi==0)wsf[32+r32]=l_reg;asm volatile("s_waitcnt lgkmcnt(0)":::"memory");
  float rli[16];
  #pragma unroll
  for(int r=0;r<16;++r)rli[r]=__builtin_amdgcn_rcpf(wsf[32+crow(r,hi)]);
  bf16*Ow=O+(rowbase+q0+wid*QBLK)*DM+vcol;
  { bf16*stg=(bf16*)(shm+LDS_OST)+wid*4096;
    #pragma unroll
    for(int r=0;r<16;++r){const int orow=crow(r,hi);
      #pragma unroll
      for(int d0=0;d0<4;++d0)stg[orow*128+d0*32+r32]=__float2bfloat16(o[d0][r]*rli[r]);}
    asm volatile("s_waitcnt lgkmcnt(0)":::"memory");
    const int ch=lane&15;
    if(MODE==0){
      #pragma unroll
      for(int i=0;i<8;++i){const int row=i*4+(lane>>4); const u32x4 v=*(const u32x4*)(stg+row*128+ch*8); ATTN_STORE16(Ow+(long)row*DM+ch*8,v);} }
    else{ const long off0=(long)(Ow-O)+(long)(lane>>4)*DM+ch*8;
      u32x4 v1[8],zw[8];
      #pragma unroll
      for(int i=0;i<8;++i){ v1[i]=*(const u32x4*)(O+off0+(long)i*4*DM); zw[i]=*(const u32x4*)(ca.ZG+off0+(long)i*4*DM); }
      const pg8::f32x4 g0=*(const pg8::f32x4*)(ca.subg+ch*8), g1=*(const pg8::f32x4*)(ca.subg+ch*8+4);
      #define BLO(w) __uint_as_float((w)<<16)
      #define BHI(w) __uint_as_float((w)&0xffff0000u)
      #pragma unroll
      for(int i=0;i<8;++i){ const int row=i*4+(lane>>4); const u32x4 v=*(const u32x4*)(stg+row*128+ch*8);
        float oo[8];
        oo[0]=BLO(v1[i].x)-ca.lam*BLO(v.x); oo[1]=BHI(v1[i].x)-ca.lam*BHI(v.x); oo[2]=BLO(v1[i].y)-ca.lam*BLO(v.y); oo[3]=BHI(v1[i].y)-ca.lam*BHI(v.y);
        oo[4]=BLO(v1[i].z)-ca.lam*BLO(v.z); oo[5]=BHI(v1[i].z)-ca.lam*BHI(v.z); oo[6]=BLO(v1[i].w)-ca.lam*BLO(v.w); oo[7]=BHI(v1[i].w)-ca.lam*BHI(v.w);
        float ss=(oo[0]*oo[0]+oo[1]*oo[1])+(oo[2]*oo[2]+oo[3]*oo[3])+(oo[4]*oo[4]+oo[5]*oo[5])+(oo[6]*oo[6]+oo[7]*oo[7]);
        ss+=__shfl_xor(ss,1); ss+=__shfl_xor(ss,2); ss+=__shfl_xor(ss,4); ss+=__shfl_xor(ss,8);
        const float ri=ca.oml/sqrtf(ss*(1.0f/128.0f)+1e-5f);
        u32x4 w; w.x=cvtpk_s(oo[0]*ri*g0[0]*BLO(zw[i].x),oo[1]*ri*g0[1]*BHI(zw[i].x)); w.y=cvtpk_s(oo[2]*ri*g0[2]*BLO(zw[i].y),oo[3]*ri*g0[3]*BHI(zw[i].y));
        w.z=cvtpk_s(oo[4]*ri*g1[0]*BLO(zw[i].z),oo[5]*ri*g1[1]*BHI(zw[i].z)); w.w=cvtpk_s(oo[6]*ri*g1[2]*BLO(zw[i].w),oo[7]*ri*g1[3]*BHI(zw[i].w));
        ATTN_STORE16(ca.A2+off0+(long)i*4*DM,w); }
      #undef BLO
      #undef BHI
    } }
  asm volatile("s_waitcnt lgkmcnt(0)\n\ts_barrier":::"memory");
  #undef QLD
  #undef DMA_K
  #undef DMA_V
  #undef CMASK
  #undef START
  #undef RESC
  #undef ROT
}
constexpr int ATTN_LDS_BYTES=LDS_BYTES;
struct AttnTensors { const bf16* Q; const bf16* K; const bf16* V; bf16* O1; };
struct AttnUnit { int b, h, qb; };
struct StaticOrder {
  int vcu, G;
  __device__ __forceinline__ explicit StaticOrder(int grid,int block):vcu((grid%8==0)?(block%8)*(grid/8)+block/8:block),G(grid){}
  __device__ __forceinline__ bool next(int i,AttnUnit&u)const{ const int r=i>>2,k=i&3; const int qd=vcu+G*r; if(qd>=256)return false; const int s=qd&7,bh=qd>>3;
    u.h=bh&7; u.b=bh>>3; u.qb=(k==0)?s:(k==1)?15-s:(k==2)?16+s:31-s; return true; }
  __device__ __forceinline__ void a_ready(const AttnUnit&)const{}
  __device__ __forceinline__ void done(const AttnUnit&)const{}
};
template<class Sched,int THRL=8> __device__ __forceinline__ void attn_phase(const int wv,char*lds,const AttnTensors&T,const Comb&ca,const Sched&S){
  AttnUnit u;
  for(int i2=0;S.next(i2>>1,u);++i2){ const int w=i2&1;
    attn_unit<THRL>(w,wv,u.b,2*u.h+w,u.h*128,u.qb,T.Q,T.K,T.V,T.O1,lds,ca); }
}
#undef SBAR
#undef WAIT_BAR
}
namespace cg = cooperative_groups;
constexpr int NWAVES = 8;
constexpr int BATCH = 4, T = 8192, D = 1024, M = BATCH * T;
constexpr int SSM_L = 32, NCH = T / SSM_L, KU = 16 * SSM_L;
constexpr float NORM_EPS = 1e-6f, SUBLN_EPS = 1e-5f;
constexpr float LAM_INIT = 0.35550906759096924f;
constexpr float QSCALE = 0.125f * 1.4426950408889634f;
constexpr int NPHASE = 10;

constexpr size_t MiB = 1u << 20;
constexpr size_t WS_CTL = 0;
constexpr size_t WS_WIN = 2 * MiB, WS_WGLU = 6 * MiB, WS_WOUT = 8 * MiB, WS_WKVQ = 10 * MiB, WS_WBO = 18 * MiB;
constexpr size_t WS_TAB = 20 * MiB, TAB_STRIDE = 286720;
constexpr size_t TAB_BPT = 0, TAB_CPT = 131072, TAB_KT = 262144, TAB_AL = 279040;
constexpr size_t WS_ROPE = 38 * MiB;
constexpr size_t WS_RINV0 = 39 * MiB, WS_LAM = 39 * MiB + 256 * 1024;
constexpr size_t WS_PSS1 = 40 * MiB, WS_PSS2 = 42 * MiB;
constexpr size_t WS_E = 48 * MiB, WS_XP = 80 * MiB;
constexpr size_t WS_S0 = 128 * MiB, WS_S1 = 192 * MiB, WS_S2 = 256 * MiB, WS_S3 = 320 * MiB, WS_S4 = 384 * MiB, WS_S5 = 448 * MiB, WS_END = 512 * MiB;
static_assert(WS_TAB + 64 * TAB_STRIDE <= WS_ROPE && WS_E + (size_t)256 * NCH * 128 * 4 <= WS_XP && WS_XP + (size_t)256 * NCH * 128 * 2 <= WS_S0, "ws map");
constexpr int LDS_BYTES = 147456, MISC_OFF = LDS_BYTES - 64;
static_assert(attn_body::ATTN_LDS_BYTES <= LDS_BYTES && pg8::STAGE_BYTES <= LDS_BYTES, "LDS map");

#define LAS __attribute__((address_space(3)))
typedef unsigned short bf16;
typedef unsigned v4u __attribute__((ext_vector_type(4)));
typedef float f32x4 __attribute__((ext_vector_type(4)));
typedef float f32x16 __attribute__((ext_vector_type(16)));
typedef short bf16x8 __attribute__((ext_vector_type(8)));
__device__ __forceinline__ unsigned f2bf(float f) { unsigned u = __builtin_bit_cast(unsigned, f); return (u + 0x7fffu + ((u >> 16) & 1u)) >> 16; }
__device__ __forceinline__ unsigned pk2(float lo, float hi) { return f2bf(lo) | (f2bf(hi) << 16); }
__device__ __forceinline__ float bf2f(bf16 v) { return __uint_as_float((unsigned)v << 16); }
__device__ __forceinline__ float wave_sum(float v) {
#pragma unroll
    for (int o = 1; o < 64; o <<= 1) v += __shfl_xor(v, o);
    return v;
}
__device__ __forceinline__ float gelu_erf(float v) { return 0.5f * v * (1.0f + erff(v * 0.70710678118654752f)); }
typedef float f32x2 __attribute__((ext_vector_type(2)));
__device__ __forceinline__ f32x2 gelu_pk(f32x2 v) {
    const f32x2 av = __builtin_elementwise_abs(v), d = av * 0.2316418882f + 1.0f;
    f32x2 t; t.x = __builtin_amdgcn_rcpf(d.x); t.y = __builtin_amdgcn_rcpf(d.y);
    f32x2 q = t * 0.5307027145f + (-0.7265760135f); q = q * t + 0.7107068705f; q = q * t + (-0.142248368f); q = q * t + 0.127414796f; q = q * t;
    const f32x2 s = (v * v) * (-0.72134752044f);
    f32x2 e; e.x = __builtin_amdgcn_exp2f(s.x); e.y = __builtin_amdgcn_exp2f(s.y);
    const f32x2 m = v * (q * e), r = v - m;
    f32x2 o; o.x = v.x < 0.f ? m.x : r.x; o.y = v.y < 0.f ? m.y : r.y; return o;
}
__device__ __forceinline__ int crow(int r, int hi) { return (r & 3) + 8 * (r >> 2) + 4 * hi; }

#define RLX_AGENT __ATOMIC_RELAXED, __HIP_MEMORY_SCOPE_AGENT
#define XB_TMO      128
#define XB_XCNT(j)  (256  + 64 * (j))
#define XB_XSUB(j)  (1280 + 64 * (j))
#define XB_XGEN(j)  (2304 + 64 * (j))
#define XB_TOP      3328
#define XB_TOPGEN   3392
#define XCD_BAR_WORDS 3456
#define XB_SPIN_CAP (1u << 22)

__device__ __forceinline__ unsigned xb_ld(unsigned* p)              { return __hip_atomic_load(p, __ATOMIC_RELAXED, __HIP_MEMORY_SCOPE_AGENT); }
__device__ __forceinline__ unsigned xb_add(unsigned* p, unsigned v) { return __hip_atomic_fetch_add(p, v, __ATOMIC_RELAXED, __HIP_MEMORY_SCOPE_AGENT); }
__device__ __forceinline__ unsigned xb_xcc_id() { return (unsigned)__builtin_amdgcn_s_getreg((3 << 11) | 20) & 0xFu; }
#define XB_SPIN(cond, bar) do { unsigned _sp = 0; while (cond) { __builtin_amdgcn_s_sleep(1); \
    if ((++_sp & 255u) == 0u) { if (xb_ld(&(bar)[XB_TMO])) break; if (_sp > XB_SPIN_CAP) { atomicAdd(&(bar)[XB_TMO], 1u); break; } } } } while (0)

struct XcdBarrier {
    unsigned* bar; unsigned x;
    volatile LAS unsigned* st;
};

__device__ __forceinline__ XcdBarrier xcd_barrier_post(unsigned* bar, volatile LAS unsigned* st, const bool t0) {
    XcdBarrier b; b.bar = bar; b.x = xb_xcc_id(); b.st = st;
    if (t0) (void)xb_add(&bar[XB_XCNT(b.x)], 1u);
    return b;
}
__device__ __forceinline__ void xcd_barrier_complete(unsigned* bar, unsigned x, unsigned& nloc, unsigned& nx) {
    const unsigned G = gridDim.x * gridDim.y * gridDim.z;
    unsigned sum, cnt, mine, sp = 0u;
    for (;;) {
        sum = 0u; cnt = 0u; mine = 0u;
#pragma unroll
        for (unsigned j = 0; j < 16; ++j) { const unsigned c = xb_ld(&bar[XB_XCNT(j)]); sum += c; cnt += (c > 0u) ? 1u : 0u; mine = (j == x) ? c : mine; }
        if (sum == G) break;
        __builtin_amdgcn_s_sleep(1);
        if ((++sp & 255u) == 0u) { if (xb_ld(&bar[XB_TMO])) break; if (sp > XB_SPIN_CAP) { atomicAdd(&bar[XB_TMO], 1u); break; } }
    }
    nloc = mine > 0u ? mine : 1u; nx = cnt > 0u ? cnt : 1u;
}

__device__ __forceinline__ void xcd_barrier(const XcdBarrier& b, const bool t0) {
    asm volatile("s_waitcnt vmcnt(0)" ::: "memory");
    __syncthreads();
    if (t0) {
        unsigned* bar = b.bar;
        __builtin_amdgcn_s_waitcnt(0);
        unsigned nloc = b.st[0], nx = b.st[1];
        if (nloc == 0u) { xcd_barrier_complete(bar, b.x, nloc, nx); b.st[0] = nloc; b.st[1] = nx; }
        const unsigned old = xb_add(&bar[XB_XSUB(b.x)], 1u);
        const unsigned gen = old / nloc;
        if (old + 1u == (gen + 1u) * nloc) {
            __builtin_amdgcn_fence(__ATOMIC_RELEASE, "agent");
            asm volatile("s_waitcnt vmcnt(0)" ::: "memory");
            const unsigned og = xb_add(&bar[XB_TOP], 1u);
            const unsigned tg = og / nx;
            if (og + 1u == (tg + 1u) * nx) xb_add(&bar[XB_TOPGEN], 1u);
            else XB_SPIN(xb_ld(&bar[XB_TOPGEN]) == tg, bar);
            __builtin_amdgcn_fence(__ATOMIC_ACQUIRE, "agent");
            xb_add(&bar[XB_XGEN(b.x)], 1u);
            asm volatile("s_waitcnt vmcnt(0)" ::: "memory");
        } else {
            XB_SPIN(xb_ld(&bar[XB_XGEN(b.x)]) == gen, bar);
            __builtin_amdgcn_fence(__ATOMIC_ACQUIRE, "agent");
            asm volatile("s_waitcnt vmcnt(0)" ::: "memory");
        }
    }
    __syncthreads();
}

struct Args { const float* in[25]; float* out; unsigned char* ws; int ph_lo, ph_hi; };
enum { I_X = 0, I_ANG, I_AINW, I_LRE, I_LIM, I_LOGDT, I_BRE, I_BIM, I_CRE, I_CIM, I_AD, I_GLUW, I_GLUB, I_AOUTW, I_KVG, I_KVW, I_BNG, I_BINW, I_LQ1, I_LK1, I_LQ2, I_LK2, I_SUBG, I_BOUTW, I_FG };

__device__ __forceinline__ void p0_transpose_item(const float* W, const float* gain, int K, int N, bf16* WT, int row_off, LAS float* scr, int item, int lane) {
    const int nblk = N / 32, kb = item / nblk, nb = item % nblk, k0 = 64 * kb, n0 = 32 * nb;
    float wv_[32];
#pragma unroll
    for (int i = 0; i < 32; ++i) wv_[i] = W[(size_t)(k0 + 2 * i + (lane >> 5)) * N + n0 + (lane & 31)];
    const float g0_ = gain ? gain[k0 + lane] : 1.0f;
#pragma unroll
    for (int i = 0; i < 32; ++i) { const int kk = 2 * i + (lane >> 5); const float gk = __shfl(g0_, kk); scr[kk * 33 + (lane & 31)] = gk * wv_[i]; }
    asm volatile("s_waitcnt lgkmcnt(0)" ::: "memory");
    const int c = lane & 7;
#pragma unroll
    for (int j = 0; j < 4; ++j) { const int n = (lane >> 3) + 8 * j; const LAS float* s = scr + (8 * c) * 33 + n;
        v4u o; o.x = pk2(s[0 * 33], s[1 * 33]); o.y = pk2(s[2 * 33], s[3 * 33]); o.z = pk2(s[4 * 33], s[5 * 33]); o.w = pk2(s[6 * 33], s[7 * 33]);
        *(v4u*)(WT + (size_t)(row_off + n0 + n) * K + k0 + 8 * c) = o; }
    asm volatile("s_waitcnt lgkmcnt(0)" ::: "memory");
}
__device__ __forceinline__ void p0_ssm_tables(const int wv, const Args& a, unsigned char* ws, LAS unsigned char* lds, int g, int qd) {
    const int tid = wv * 64 + pg8::lane_id();
    LAS float* pwr = (LAS float*)lds;
    LAS float* pwi = pwr + 33 * 64;
    LAS float* bbr = pwi + 33 * 64;
    LAS float* bbi = bbr + 1024;
    LAS float* ccr = bbi + 1024;
    LAS float* cci = ccr + 1024;
    const float* lam_re = a.in[I_LRE]; const float* lam_im = a.in[I_LIM]; const float* log_dt = a.in[I_LOGDT];
    const float dt = expf(log_dt[g]);
    { const int p = tid & 63; const float lr = lam_re[g * 64 + p], li = lam_im[g * 64 + p];
      for (int tau = tid >> 6; tau <= SSM_L; tau += 8) { const float mg = expf(lr * dt * (float)tau), an = li * dt * (float)tau; pwr[tau * 64 + p] = mg * cosf(an); pwi[tau * 64 + p] = mg * sinf(an); }
      const float mg = expf(lr * dt), an = li * dt, ar = mg * cosf(an), ai = mg * sinf(an);
      const float den = lr * lr + li * li, nr = ar - 1.0f, ni = ai, fr = (nr * lr + ni * li) / den, fi = (ni * lr - nr * li) / den;
      for (int j = tid >> 6; j < 16; j += 8) { const float br = a.in[I_BRE][(size_t)(g * 64 + p) * 16 + j], bi = a.in[I_BIM][(size_t)(g * 64 + p) * 16 + j]; bbr[p * 16 + j] = fr * br - fi * bi; bbi[p * 16 + j] = fr * bi + fi * br; }
      for (int i = tid >> 6; i < 16; i += 8) { ccr[i * 64 + p] = a.in[I_CRE][(size_t)(g * 16 + i) * 64 + p]; cci[i * 64 + p] = a.in[I_CIM][(size_t)(g * 16 + i) * 64 + p]; }
    }
    __syncthreads();
    unsigned char* tg = ws + WS_TAB + (size_t)g * TAB_STRIDE;
    bf16* bpt = (bf16*)(tg + TAB_BPT); bf16* cpt = (bf16*)(tg + TAB_CPT); bf16* kt = (bf16*)(tg + TAB_KT); float* al = (float*)(tg + TAB_AL);
    for (int e = qd * 16384 + tid; e < (qd + 1) * 16384; e += 512) { const int pp = e / KU, sj = e % KU, s = sj >> 4, j = sj & 15, p = pp & 63, tau = SSM_L - 1 - s;
        const float wr = pwr[tau * 64 + p], wi = pwi[tau * 64 + p], br = bbr[p * 16 + j], bi = bbi[p * 16 + j];
        bpt[e] = (bf16)f2bf(pp < 64 ? wr * br - wi * bi : wr * bi + wi * br); }
    for (int e = qd * 16384 + tid; e < (qd + 1) * 16384; e += 512) { const int ti = e >> 7, pp = e & 127, t = ti >> 4, i = ti & 15, p = pp & 63;
        const float wr = pwr[(t + 1) * 64 + p], wi = pwi[(t + 1) * 64 + p], cr = ccr[i * 64 + p], ci = cci[i * 64 + p];
        cpt[e] = (bf16)f2bf(pp < 64 ? cr * wr - ci * wi : -(cr * wi + ci * wr)); }
    for (int e = qd * 2112 + tid; e < (qd + 1) * 2112; e += 512) { const int t1 = e >> 8, rest = e & 255, hi = rest >> 7, i = (rest & 127) >> 3, j = hi * 8 + (rest & 7);
        float s = 0.f;
        if (t1 > 0) { const int tau = t1 - 1;
            for (int p = 0; p < 64; ++p) { const float wr = pwr[tau * 64 + p], wi = pwi[tau * 64 + p], br = bbr[p * 16 + j], bi = bbi[p * 16 + j];
                s += ccr[i * 64 + p] * (wr * br - wi * bi) - cci[i * 64 + p] * (wr * bi + wi * br); } }
        if (t1 == 1 && i == j) s += a.in[I_AD][g * 16 + i];
        kt[e] = (bf16)f2bf(s); }
    if (qd == 0 && tid < 128) al[tid] = tid < 64 ? pwr[SSM_L * 64 + tid] : pwi[SSM_L * 64 + tid - 64];
    __syncthreads();
}

__device__ __forceinline__ void ssm_phase(LAS unsigned char* lds, const bf16* U, bf16* YG, const unsigned char* tab, float* Eg, bf16* XPg, const float* dskip, int vcu, int G, const int wv) {
    const int wid = wv;
    for (int item = vcu; item < 256; item += G) {
        const int lane = pg8::lane_id_v(), tid = wv * 64 + lane, r32 = lane & 31, hi = lane >> 5;
        const int b = item >> 6, g = item & 63;
        const unsigned char* tg = tab + (size_t)g * TAB_STRIDE;
        const bf16* Ub = U + (size_t)item * T * 16;
        bf16* XP = XPg + (size_t)item * NCH * 128;
        const bf16* ua = Ub + (size_t)((wid * 32 + r32) * SSM_L) * 16 + hi * 8;
        {
            const unsigned char* gsrc = tg + TAB_BPT + (size_t)tid * 16; LAS unsigned char* ldst = lds + (tid >> 6) * 1040 + (tid & 63) * 16;
            for (int h2 = 0; h2 < 2; ++h2) { v4u tb[8];
#pragma unroll
                for (int k = 0; k < 8; ++k) tb[k] = *(const v4u*)(gsrc + k * 8192);
#pragma unroll
                for (int k = 0; k < 8; ++k) *(LAS v4u*)(ldst + k * 8320) = tb[k];
                gsrc += 65536; ldst += 8 * 8320; } }
        __syncthreads();
        {
            f32x16 acc[4];
#pragma unroll
            for (int n = 0; n < 4; ++n) acc[n] = f32x16{};
            const LAS unsigned char* bb = lds + r32 * 1040 + hi * 16;
            bf16x8 uc[8];
#pragma unroll
            for (int j = 0; j < 8; ++j) uc[j] = *(const bf16x8*)(ua + (size_t)j * 16);
            for (int bt = 0; bt < 4; ++bt) {
                bf16x8 un[8];
                if (bt < 3) {
#pragma unroll
                    for (int j = 0; j < 8; ++j) un[j] = *(const bf16x8*)(ua + (size_t)(8 * bt + 8 + j) * 16); }
                const LAS unsigned char* bq = bb + bt * 256;
                bf16x8 bc[4], bn[4];
#pragma unroll
                for (int n = 0; n < 4; ++n) bc[n] = *(const LAS bf16x8*)(bq + n * 32 * 1040);
#pragma unroll
                for (int j = 0; j < 8; ++j) {
                    if (j < 7) {
#pragma unroll
                        for (int n = 0; n < 4; ++n) bn[n] = *(const LAS bf16x8*)(bq + n * 32 * 1040 + (j + 1) * 32); }
#pragma unroll
                    for (int n = 0; n < 4; ++n) acc[n] = __builtin_amdgcn_mfma_f32_32x32x16_bf16(uc[j], bc[n], acc[n], 0, 0, 0);
                    if (j < 7) {
#pragma unroll
                        for (int n = 0; n < 4; ++n) bc[n] = bn[n]; }
                }
                if (bt < 3) {
#pragma unroll
                    for (int j = 0; j < 8; ++j) uc[j] = un[j]; }
            }
            __syncthreads();
            LAS float* El = (LAS float*)lds;
#pragma unroll
            for (int n = 0; n < 4; ++n)
#pragma unroll
                for (int r = 0; r < 16; ++r) El[(wid * 32 + crow(r, hi)) * 128 + n * 32 + r32] = acc[n][r];
        }
        __syncthreads();
        {
            const float* al = (const float*)(tg + TAB_AL); const float ar = al[lane], ai = al[64 + lane];
            const LAS float* ep = (const LAS float*)lds + (wid * 32) * 128 + lane;
            float xr = 0.f, xi = 0.f;
            for (int kb = 0; kb < 4; ++kb) { float er[8], ei[8];
#pragma unroll
                for (int k = 0; k < 8; ++k) { er[k] = ep[k * 128]; ei[k] = ep[k * 128 + 64]; }
#pragma unroll
                for (int k = 0; k < 8; ++k) { const float nr = ar * xr - ai * xi + er[k], ni = ar * xi + ai * xr + ei[k]; xr = nr; xi = ni; }
                ep += 8 * 128; }
            LAS float* sg = (LAS float*)(lds + 131072);
            sg[(wid * 64 + lane) * 2] = xr; sg[(wid * 64 + lane) * 2 + 1] = xi;
            __syncthreads();
            float pr = ar, pi = ai;
#pragma unroll
            for (int k = 0; k < 5; ++k) { const float nr = pr * pr - pi * pi, ni = 2.0f * pr * pi; pr = nr; pi = ni; }
            float sr = 0.f, si = 0.f;
            for (int s2 = 0; s2 < wid; ++s2) { const float zr = sg[(s2 * 64 + lane) * 2], zi = sg[(s2 * 64 + lane) * 2 + 1]; const float nr = pr * sr - pi * si + zr, ni = pr * si + pi * sr + zi; sr = nr; si = ni; }
            xr = sr; xi = si;
            ep = (const LAS float*)lds + (wid * 32) * 128 + lane; bf16* xp = XP + (size_t)(wid * 32) * 128 + lane;
            for (int kb = 0; kb < 4; ++kb) { float er[8], ei[8];
#pragma unroll
                for (int k = 0; k < 8; ++k) { er[k] = ep[k * 128]; ei[k] = ep[k * 128 + 64]; }
#pragma unroll
                for (int k = 0; k < 8; ++k) { xp[k * 128] = (bf16)f2bf(xr); xp[k * 128 + 64] = (bf16)f2bf(xi);
                    const float nr = ar * xr - ai * xi + er[k], ni = ar * xi + ai * xr + ei[k]; xr = nr; xi = ni; }
                ep += 8 * 128; xp += 8 * 128; }
        }
        __syncthreads();
        constexpr int KT_LDS = 256 * 272;
        for (int half = 0; half < 2; ++half) {
            {   v4u tb[8], tk[3];
                const unsigned char* gsrc = tg + TAB_CPT + (size_t)half * 65536 + (size_t)tid * 16; LAS unsigned char* ldst = lds + (tid >> 4) * 272 + (tid & 15) * 16;
                const unsigned char* ksrc = tg + TAB_KT + (size_t)tid * 16; LAS unsigned char* kdst = lds + KT_LDS + tid * 16;
#pragma unroll
                for (int k = 0; k < 8; ++k) tb[k] = *(const v4u*)(gsrc + k * 8192);
                if (half == 0) { tk[0] = *(const v4u*)ksrc; tk[1] = *(const v4u*)(ksrc + 8192); if (tid < 32) tk[2] = *(const v4u*)(ksrc + 16384); }
#pragma unroll
                for (int k = 0; k < 8; ++k) *(LAS v4u*)(ldst + k * 8704) = tb[k];
                if (half == 0) { *(LAS v4u*)kdst = tk[0]; *(LAS v4u*)(kdst + 8192) = tk[1]; if (tid < 32) *(LAS v4u*)(kdst + 16384) = tk[2]; } }
            __syncthreads();
            for (int qq = 0; qq < 2; ++qq) {
                const int q = half * 2 + qq;
                f32x16 acc[4];
#pragma unroll
                for (int n = 0; n < 4; ++n) acc[n] = f32x16{};
                const LAS unsigned char* kb = lds + KT_LDS + (r32 >> 4) * 512 + hi * 256 + (r32 & 15) * 16;
                const bf16* xa = XP + (size_t)(wid * 32 + r32) * 128 + hi * 8;
                const LAS unsigned char* cb = lds + (qq * 128 + r32) * 272 + hi * 16;
                bf16x8 uc[8];
#pragma unroll
                for (int j = 0; j < 8; ++j) uc[j] = *(const bf16x8*)(ua + (size_t)j * 16);
                for (int bt = 0; bt < q; ++bt) {
                    bf16x8 un[8];
#pragma unroll
                    for (int j = 0; j < 8; ++j) un[j] = *(const bf16x8*)(ua + (size_t)(8 * bt + 8 + j) * 16);
                    const LAS unsigned char* kq = kb + (8 * (q - bt) + 1) * 512;
                    bf16x8 bc[4], bn[4];
#pragma unroll
                    for (int n = 0; n < 4; ++n) bc[n] = *(const LAS bf16x8*)(kq + (2 * n) * 512);
#pragma unroll
                    for (int j = 0; j < 8; ++j) {
                        if (j < 7) {
#pragma unroll
                            for (int n = 0; n < 4; ++n) bn[n] = *(const LAS bf16x8*)(kq + (2 * n - (j + 1)) * 512); }
#pragma unroll
                        for (int n = 0; n < 4; ++n) acc[n] = __builtin_amdgcn_mfma_f32_32x32x16_bf16(bc[n], uc[j], acc[n], 0, 0, 0);
                        if (j < 7) {
#pragma unroll
                            for (int n = 0; n < 4; ++n) bc[n] = bn[n]; }
                    }
#pragma unroll
                    for (int j = 0; j < 8; ++j) uc[j] = un[j];
                }
#pragma unroll
                for (int j = 0; j < 8; ++j) {
                    bf16x8 bd[4];
#pragma unroll
                    for (int n = 0; n < 4; ++n) if (j <= 2 * n + 1) bd[n] = *(const LAS bf16x8*)(kb + (2 * n - j + 1) * 512);
#pragma unroll
                    for (int n = 0; n < 4; ++n) if (j <= 2 * n + 1) acc[n] = __builtin_amdgcn_mfma_f32_32x32x16_bf16(bd[n], uc[j], acc[n], 0, 0, 0);
                }
                {   bf16x8 bc[4], bn[4];
                    bf16x8 xv[8];
#pragma unroll
                    for (int ks = 0; ks < 8; ++ks) xv[ks] = *(const bf16x8*)(xa + ks * 16);
#pragma unroll
                    for (int n = 0; n < 4; ++n) bc[n] = *(const LAS bf16x8*)(cb + n * 32 * 272);
#pragma unroll
                    for (int ks = 0; ks < 8; ++ks) {
                        if (ks < 7) {
#pragma unroll
                            for (int n = 0; n < 4; ++n) bn[n] = *(const LAS bf16x8*)(cb + n * 32 * 272 + (ks + 1) * 32); }
#pragma unroll
                        for (int n = 0; n < 4; ++n) acc[n] = __builtin_amdgcn_mfma_f32_32x32x16_bf16(bc[n], xv[ks], acc[n], 0, 0, 0);
                        if (ks < 7) {
#pragma unroll
                            for (int n = 0; n < 4; ++n) bc[n] = bn[n]; }
                    }
                }
                const size_t rbase = ((size_t)b * T + (size_t)(wid * 32 + r32) * SSM_L) * 1024 + g * 16 + 8 * hi;
#pragma unroll
                for (int n = 0; n < 4; ++n)
#pragma unroll
                    for (int ap = 0; ap < 2; ++ap) { const int a0 = 2 * ap, a1 = 2 * ap + 1;
                        const f32x2 xa = gelu_pk((f32x2){acc[n][4 * a0 + 0], acc[n][4 * a0 + 1]}), xb = gelu_pk((f32x2){acc[n][4 * a0 + 2], acc[n][4 * a0 + 3]});
                        const f32x2 ya = gelu_pk((f32x2){acc[n][4 * a1 + 0], acc[n][4 * a1 + 1]}), yb = gelu_pk((f32x2){acc[n][4 * a1 + 2], acc[n][4 * a1 + 3]});
                        const auto r0 = __builtin_amdgcn_permlane32_swap(pk2(xa.x, xa.y), pk2(ya.x, ya.y), false, false);
                        const auto r1 = __builtin_amdgcn_permlane32_swap(pk2(xb.x, xb.y), pk2(yb.x, yb.y), false, false);
                        v4u w; w.x = r0[0]; w.y = r1[0]; w.z = r0[1]; w.w = r1[1];
                        *(v4u*)(YG + rbase + (size_t)(8 * q + 2 * n + ap) * 1024) = w; }
            }
            __syncthreads();
        }
    }
}

__global__ void __launch_bounds__(NWAVES * 64, 2) mega(Args args) {
    extern __shared__ __attribute__((aligned(16))) unsigned char lds_raw[];
    LAS unsigned char* lds = (LAS unsigned char*)lds_raw;
    const int wave = __builtin_amdgcn_readfirstlane(threadIdx.x >> 6);
#define lane (pg8::lane_id())
#define tid (wave * 64 + pg8::lane_id())
    const int G = gridDim.x; const int bx = blockIdx.x; const int vcu = (G % 8 == 0) ? (bx % 8) * (G / 8) + bx / 8 : bx;
#define ws (args.ws)
    const int lo = args.ph_lo, hi = args.ph_hi;
    volatile LAS unsigned* MISC = (volatile LAS unsigned*)(lds + MISC_OFF);
    XcdBarrier xbar; xbar.bar = (unsigned*)(ws + WS_CTL) + 4096; xbar.x = 0; xbar.st = nullptr;
    if (lo < -1000) cg::this_grid().sync();
    if (hi - lo > 1) { if (pg8::lane_id() < 16 && wave == 0) MISC[pg8::lane_id()] = 0u; __syncthreads(); xbar = xcd_barrier_post((unsigned*)(ws + WS_CTL) + 4096, MISC + 8, wave == 0 && pg8::lane_id() == 0); }
#define IN(k) (lo <= (k) && (k) < hi)
#define SEAM(k) do { if (IN(k) && IN((k) + 1)) { xcd_barrier(xbar, tid == 0); } } while (0)
#define WIN ((bf16*)(ws + WS_WIN))
#define WGLU ((bf16*)(ws + WS_WGLU))
#define WOUT ((bf16*)(ws + WS_WOUT))
#define WKVQ ((bf16*)(ws + WS_WKVQ))
#define WBO ((bf16*)(ws + WS_WBO))
#define ropec ((float*)(ws + WS_ROPE))
#define ropes ((float*)(ws + WS_ROPE + 256 * 1024))
#define rinv0 ((float*)(ws + WS_RINV0))
#define lamv ((float*)(ws + WS_LAM))
#define PSS1 ((float*)(ws + WS_PSS1))
#define PSS2 ((float*)(ws + WS_PSS2))
#define XB ((bf16*)(ws + WS_S0))
#define YG ((bf16*)(ws + WS_S0))
#define H1B ((bf16*)OUTP)
#define H2B ((bf16*)(ws + WS_S3))
#define O1 ((bf16*)(ws + WS_S0))
#define U ((bf16*)(ws + WS_S1))
#define Y2 ((bf16*)(ws + WS_S1))
#define KB ((bf16*)(ws + WS_S1))
#define A2 ((bf16*)(ws + WS_S5))
#define ZG ((bf16*)(ws + WS_S2))
#define VB ((bf16*)(ws + WS_S2))
#define QB ((bf16*)(ws + WS_S3))
#define ZG2 ((bf16*)(ws + WS_S4))
#define O2 ((bf16*)(ws + WS_S5))
#define XIN (args.in[I_X])
#define OUTP (args.out)
#define gw (vcu * NWAVES + wave)
#define NGW (G * NWAVES)

    if (IN(0)) {
        LAS float* scr = (LAS float*)(lds + wave * 16384);
        constexpr int I_1 = 16 * 64, I_2 = 16 * 32;
        constexpr int NITEMS = 3 * I_1 + 3 * I_2;
        for (int it = gw; it < NITEMS; it += NGW) {
            int r = it;
            if (r < I_1) { p0_transpose_item(args.in[I_AINW], args.in[I_ANG], D, 2048, WIN, 0, scr, r, lane); continue; } r -= I_1;
            if (r < I_1) { p0_transpose_item(args.in[I_KVW], args.in[I_KVG], D, 2048, WKVQ, 0, scr, r, lane); continue; } r -= I_1;
            if (r < I_1) { p0_transpose_item(args.in[I_BINW], args.in[I_BNG], D, 2048, WKVQ, 2048, scr, r, lane); continue; } r -= I_1;
            if (r < I_2) { p0_transpose_item(args.in[I_GLUW], nullptr, D, 1024, WGLU, 0, scr, r, lane); continue; } r -= I_2;
            if (r < I_2) { p0_transpose_item(args.in[I_AOUTW], nullptr, D, 1024, WOUT, 0, scr, r, lane); continue; } r -= I_2;
            p0_transpose_item(args.in[I_BOUTW], nullptr, D, 1024, WBO, 0, scr, r, lane);
        }
        for (int m0 = gw; m0 < M; m0 += 4 * NGW) {
            f32x4 v[4][4];
#pragma unroll
            for (int k = 0; k < 4; ++k) { const int m = m0 + k * NGW; if (m < M) { const f32x4* xr = (const f32x4*)(XIN + (size_t)m * D) + lane;
#pragma unroll
                for (int j = 0; j < 4; ++j) v[k][j] = xr[64 * j]; } }
#pragma unroll
            for (int k = 0; k < 4; ++k) { const int m = m0 + k * NGW; if (m < M) { float s = 0.f;
#pragma unroll
                for (int j = 0; j < 4; ++j) s += (v[k][j].x * v[k][j].x + v[k][j].y * v[k][j].y) + (v[k][j].z * v[k][j].z + v[k][j].w * v[k][j].w);
                s = wave_sum(s); if (lane == 0) rinv0[m] = 1.0f / sqrtf(s * (1.0f / D) + NORM_EPS);
                unsigned long long* o8 = (unsigned long long*)(XB + (size_t)m * D) + lane;
#pragma unroll
                for (int j = 0; j < 4; ++j) o8[64 * j] = (unsigned long long)pk2(v[k][j].x, v[k][j].y) | ((unsigned long long)pk2(v[k][j].z, v[k][j].w) << 32); } }
        }
        for (int e = vcu * 512 + tid; e < T * 8; e += G * 512) { const int pos = e >> 3, i = e & 7; const float inv = powf(500000.0f, -(float)i / 8.0f); const float an = (float)pos * inv; ropec[e] = cosf(an); ropes[e] = sinf(an); }
        if (bx == 0 && wave == 0) { const float a1 = wave_sum(args.in[I_LQ1][lane] * args.in[I_LK1][lane]), a2 = wave_sum(args.in[I_LQ2][lane] * args.in[I_LK2][lane]); if (lane == 0) lamv[0] = expf(a1) - expf(a2) + LAM_INIT; }
        __syncthreads();
        for (int it = vcu; it < 256; it += G) p0_ssm_tables(wave, args, ws, lds, it >> 2, it & 3);
    }
    SEAM(0);
    if (IN(1)) {
        pg8::Gemm g{XB, WIN, M, 2048, D}; pg8::StaticOrder S; S.init(M, 2048, G, bx);
        pg8::EpiUZ E{U, ZG, rinv0};
        pg8::gemm_phase<pg8::EpiUZ, pg8::StaticOrder, true, true>(wave, lds, g, S, E);
    }
    SEAM(1);
    if (IN(2)) ssm_phase(lds, U, YG, ws + WS_TAB, (float*)(ws + WS_E), (bf16*)(ws + WS_XP), args.in[I_AD], vcu, G, wave);
    SEAM(2);
    if (IN(3)) {
        pg8::Gemm g{YG, WGLU, M, 1024, D}; pg8::StaticOrder S; S.init(M, 1024, G, bx);
        pg8::EpiGlu E{YG, ZG, args.in[I_GLUB], Y2};
        pg8::gemm_phase<pg8::EpiGlu, pg8::StaticOrder, true, true>(wave, lds, g, S, E);
    }
    SEAM(3);
    if (IN(4)) {
        pg8::Gemm g{Y2, WOUT, M, 1024, D}; pg8::StaticOrder S; S.init(M, 1024, G, bx);
        pg8::EpiRes<false> E{XIN, H1B, PSS1};
        pg8::gemm_phase<pg8::EpiRes<false>, pg8::StaticOrder, true, true>(wave, lds, g, S, E);
    }
    SEAM(4);
    if (IN(5)) {
        pg8::Gemm g{H1B, WKVQ, M, 4096, D}; pg8::StaticOrder S; S.init(M, 4096, G, bx);
        pg8::EpiKVQZ E{KB, VB, QB, ZG2, PSS1, ropec, ropes, QSCALE};
        pg8::gemm_phase<pg8::EpiKVQZ, pg8::StaticOrder, true, true>(wave, lds, g, S, E);
    }
    SEAM(5);
    if (IN(6)) {
        const attn_body::AttnTensors AT{(const attn_body::bf16*)QB, (const attn_body::bf16*)KB, (const attn_body::bf16*)VB, (attn_body::bf16*)O1};
        const attn_body::Comb CA{(const attn_body::bf16*)ZG2, (attn_body::bf16*)A2, args.in[I_SUBG], lamv[0], 1.0f - LAM_INIT};
        const attn_body::StaticOrder S(G, bx);
        attn_body::attn_phase<attn_body::StaticOrder>(wave, (char*)lds_raw, AT, CA, S);
    }
    if (IN(6) && IN(8)) xcd_barrier(xbar, tid == 0);
    if (IN(8)) {
        pg8::Gemm g{A2, WBO, M, 1024, D}; pg8::StaticOrder S; S.init(M, 1024, G, bx);
        pg8::EpiRes<true> E{H1B, H2B, PSS2};
        pg8::gemm_phase<pg8::EpiRes<true>, pg8::StaticOrder, true, true>(wave, lds, g, S, E);
    }
    SEAM(8);
    if (IN(9)) {
        const float* fg = args.in[I_FG];
        const f32x4* gr = (const f32x4*)fg + 4 * lane; const f32x4 g0 = gr[0], g1 = gr[1], g2 = gr[2], g3 = gr[3];
        for (int m0 = gw; m0 < M; m0 += 4 * NGW) {
            v4u h0[4], h1[4]; float ps[4];
#pragma unroll
            for (int k = 0; k < 4; ++k) { const int m = m0 + k * NGW; if (m < M) { h0[k] = *((const v4u*)(H2B + (size_t)m * D) + 2 * lane); h1[k] = *((const v4u*)(H2B + (size_t)m * D) + 2 * lane + 1); ps[k] = lane < 16 ? PSS2[(size_t)m * 16 + lane] : 0.f; } }
#pragma unroll
            for (int k = 0; k < 4; ++k) { const int m = m0 + k * NGW; if (m < M) { const float ri = 1.0f / sqrtf(wave_sum(ps[k]) * (1.0f / D) + NORM_EPS);
                f32x4* orow = (f32x4*)(OUTP + (size_t)m * D) + 4 * lane;
                orow[0] = (f32x4){pg8::bf_lo(h0[k].x), pg8::bf_hi(h0[k].x), pg8::bf_lo(h0[k].y), pg8::bf_hi(h0[k].y)} * ri * g0;
                orow[1] = (f32x4){pg8::bf_lo(h0[k].z), pg8::bf_hi(h0[k].z), pg8::bf_lo(h0[k].w), pg8::bf_hi(h0[k].w)} * ri * g1;
                orow[2] = (f32x4){pg8::bf_lo(h1[k].x), pg8::bf_hi(h1[k].x), pg8::bf_lo(h1[k].y), pg8::bf_hi(h1[k].y)} * ri * g2;
                orow[3] = (f32x4){pg8::bf_lo(h1[k].z), pg8::bf_hi(h1[k].z), pg8::bf_lo(h1[k].w), pg8::bf_hi(h1[k].w)} * ri * g3; } }
        }
    }
#undef IN
#undef SEAM
#undef WIN
#undef WGLU
#undef WOUT
#undef WKVQ
#undef WBO
#undef ropec
#undef ropes
#undef rinv0
#undef lamv
#undef PSS1
#undef PSS2
#undef XB
#undef YG
#undef H1B
#undef H2B
#undef O1
#undef U
#undef Y2
#undef KB
#undef A2
#undef ZG
#undef VB
#undef QB
#undef ZG2
#undef O2
#undef lane
#undef tid
#undef XIN
#undef OUTP
#undef gw
#undef NGW
#undef ws
}

static void launch_mega(int grid, Args a, int lo, int hi, hipStream_t stream) {
    a.ph_lo = lo; a.ph_hi = hi;
    { void* kargs[] = {&a}; hipError_t e = hipLaunchCooperativeKernel((const void*)mega, dim3(grid), dim3(NWAVES * 64), kargs, LDS_BYTES, stream);
        if (e != hipSuccess) fprintf(stderr, "kernel_launch: cooperative launch failed: %s (grid %d)\n", hipGetErrorString(e), grid); }
}
extern "C" void kernel_launch(void* const* d_in, const int* in_sizes, int n_in, void* d_out, int out_size, void* d_ws, size_t ws_size, hipStream_t stream) {
    static int grid = 0;
    if (grid == 0) {
        if (n_in != 25 || in_sizes[0] != M * D || out_size != M * D || ws_size < WS_END) { fprintf(stderr, "kernel_launch: unexpected shapes (n_in %d, in0 %d, out %d, ws %zu); nothing launched\n", n_in, n_in > 0 ? in_sizes[0] : -1, out_size, ws_size); grid = -1; return; }
        int dev = 0, cus = 0, per_cu = 0;
        if (hipGetDevice(&dev) != hipSuccess || hipDeviceGetAttribute(&cus, hipDeviceAttributeMultiprocessorCount, dev) != hipSuccess) { grid = -1; return; }
        if (hipFuncSetAttribute((const void*)mega, hipFuncAttributeMaxDynamicSharedMemorySize, LDS_BYTES) != hipSuccess) { fprintf(stderr, "kernel_launch: hipFuncSetAttribute failed\n"); grid = -1; return; }
        if (hipOccupancyMaxActiveBlocksPerMultiprocessor(&per_cu, (const void*)mega, NWAVES * 64, LDS_BYTES) != hipSuccess || per_cu < 1) { fprintf(stderr, "kernel_launch: occupancy query gave %d\n", per_cu); per_cu = 1; }
        (void)hipGetLastError();
        if (per_cu > 1) per_cu = 1;
        grid = cus * per_cu;
    }
    if (grid < 0) return;
    Args a{};
    for (int i = 0; i < 25; ++i) a.in[i] = (const float*)d_in[i];
    a.out = (float*)d_out; a.ws = (unsigned char*)d_ws;
    if (hipMemsetAsync((char*)d_ws + WS_CTL, 0, 65536, stream) != hipSuccess) { fprintf(stderr, "kernel_launch: memset failed\n"); return; }
    launch_mega(grid, a, 0, NPHASE, stream);
}
```
